# Optimizing an MI355X kernel written in HIP

```python
import jax, jax.numpy as jnp
from jax import lax
import numpy as np

D_MODEL = 1024
BATCH = 4
SEQ = 8192
DEPTH = 1

SB_HEADS = 8
SB_HEAD_DIM = 128
SB_WIDTH = SB_HEADS * SB_HEAD_DIM
GLA_HEADS = 4
GLA_KEY_DIM = 128
GLA_VAL_DIM = 256
GLA_KEY_WIDTH = GLA_HEADS * GLA_KEY_DIM
GLA_WIDTH = GLA_HEADS * GLA_VAL_DIM
D_INNER = SB_WIDTH + GLA_WIDTH
GATE_RANK = 16
GATE_TEMP = 16.0
SB_BLOCK = 128
GLA_CHUNK = 64
NORM_EPS = 1e-6
IN_SIZES = (SB_WIDTH, SB_WIDTH, SB_WIDTH, SB_WIDTH,
            GLA_KEY_WIDTH, GLA_KEY_WIDTH, GLA_WIDTH, GLA_WIDTH, GATE_RANK)
IN_PROJ_WIDTH = sum(IN_SIZES)

kernel_name = "hymba_stickbreak_gla_block"


def rmsnorm(x, w):
    xf = x.astype(jnp.float32)
    xf = xf * lax.rsqrt(jnp.mean(xf * xf, axis=-1, keepdims=True) + NORM_EPS)
    return (xf * w.astype(jnp.float32)).astype(x.dtype)


def head_rmsnorm(o, w, n_heads):
    B, S, W = o.shape
    oh = o.reshape(B, S, n_heads, W // n_heads)
    return rmsnorm(oh, w.reshape(n_heads, W // n_heads)).reshape(B, S, W)


def split_heads(t, n_heads):
    B, S, W = t.shape
    return t.reshape(B, S, n_heads, W // n_heads).transpose(0, 2, 1, 3)


def merge_heads(t):
    B, H, S, d = t.shape
    return t.transpose(0, 2, 1, 3).reshape(B, S, H * d)


def stick_breaking_attention(q, k, v):
    B, H, S, d = q.shape
    nb = S // SB_BLOCK
    qf = q.astype(jnp.float32) * (d ** -0.5)
    kf = k.astype(jnp.float32)
    vf = v.astype(jnp.float32)
    q_blocks = qf.reshape(B, H, nb, SB_BLOCK, d).transpose(2, 0, 1, 3, 4)
    pos = jnp.arange(SB_BLOCK)
    strict_lower = pos[None, :] < pos[:, None]
    all_valid = jnp.ones((SB_BLOCK, SB_BLOCK), dtype=bool)

    def one_query_block(args):
        i, qb = args

        def body(n, carry):
            acc, logsurv = carry
            j = i - n
            kb = lax.dynamic_slice_in_dim(kf, j * SB_BLOCK, SB_BLOCK, axis=2)
            vb = lax.dynamic_slice_in_dim(vf, j * SB_BLOCK, SB_BLOCK, axis=2)
            z = jnp.einsum('bhtd,bhsd->bhts', qb, kb)
            valid = jnp.where(j == i, strict_lower, all_valid)
            log_fail = jnp.where(valid, jax.nn.log_sigmoid(-z), 0.0)
            after = lax.cumsum(log_fail, axis=3, reverse=True) - log_fail
            log_w = jax.nn.log_sigmoid(z) + after + logsurv[..., None]
            w = jnp.where(valid, jnp.exp(log_w), 0.0)
            acc = acc + jnp.einsum('bhts,bhsd->bhtd', w, vb)
            logsurv = logsurv + jnp.sum(log_fail, axis=3)
            return acc, logsurv

        init = (jnp.zeros((B, H, SB_BLOCK, d), jnp.float32),
                jnp.zeros((B, H, SB_BLOCK), jnp.float32))
        acc, _ = lax.fori_loop(0, i + 1, body, init)
        return acc

    out = lax.map(one_query_block, (jnp.arange(nb, dtype=jnp.int32), q_blocks))
    return out.transpose(1, 2, 0, 3, 4).reshape(B, H, S, d).astype(v.dtype)


def gla_chunked(q, k, v, log_a):
    B, H, S, dk = q.shape
    dv = v.shape[-1]
    C = GLA_CHUNK
    nc = S // C

    def to_chunks(t):
        return t.astype(jnp.float32).reshape(B, H, nc, C, t.shape[-1]).transpose(2, 0, 1, 3, 4)

    qc, kc, vc, gc = to_chunks(q), to_chunks(k), to_chunks(v), to_chunks(log_a)
    causal = (jnp.arange(C)[None, :] <= jnp.arange(C)[:, None])[None, None, :, :, None]

    def step(state, inp):
        qb, kb, vb, gb = inp
        b = jnp.cumsum(gb, axis=2)
        diff = b[:, :, :, None, :] - b[:, :, None, :, :]
        decay = jnp.where(causal, jnp.exp(jnp.where(causal, diff, 0.0)), 0.0)
        scores = jnp.einsum('bhtd,bhsd,bhtsd->bhts', qb, kb, decay)
        o_intra = jnp.einsum('bhts,bhsv->bhtv', scores, vb)
        o_inter = jnp.einsum('bhtd,bhdv->bhtv', qb * jnp.exp(b), state)
        b_last = b[:, :, -1:, :]
        state = (jnp.exp(b_last[:, :, 0, :])[..., None] * state
                 + jnp.einsum('bhsd,bhsv->bhdv', kb * jnp.exp(b_last - b), vb))
        return state, o_intra + o_inter

    state0 = jnp.zeros((B, H, dk, dv), jnp.float32)
    _, out = lax.scan(step, state0, (qc, kc, vc, gc))
    return out.transpose(1, 2, 0, 3, 4).reshape(B, H, S, dv).astype(v.dtype)


def hybrid_layer(x, pre_norm_w, w_in, w_alpha2, b_alpha2, sb_norm_w, gla_norm_w, w_out, post_norm_w):
    h = rmsnorm(x, pre_norm_w)
    proj = jnp.einsum('bsd,de->bse', h, w_in)
    offsets = np.cumsum(np.array(IN_SIZES))[:-1].tolist()
    (sb_q, sb_k, sb_v, sb_gate,
     gla_q, gla_k, gla_v, gla_gate, gla_lr) = jnp.split(proj, offsets, axis=-1)

    sb_o = stick_breaking_attention(split_heads(sb_q, SB_HEADS),
                                    split_heads(sb_k, SB_HEADS),
                                    split_heads(sb_v, SB_HEADS))
    sb_y = head_rmsnorm(merge_heads(sb_o), sb_norm_w, SB_HEADS) * jax.nn.silu(sb_gate)

    gate_logits = jnp.einsum('bsr,rk->bsk', gla_lr, w_alpha2) + b_alpha2
    log_a = jax.nn.log_sigmoid(gate_logits.astype(jnp.float32)) / GATE_TEMP
    gla_o = gla_chunked(split_heads(gla_q * (GLA_KEY_DIM ** -0.5), GLA_HEADS),
                        split_heads(gla_k, GLA_HEADS),
                        split_heads(gla_v, GLA_HEADS),
                        split_heads(log_a, GLA_HEADS))
    gla_y = head_rmsnorm(merge_heads(gla_o), gla_norm_w, GLA_HEADS) * jax.nn.silu(gla_gate)

    y = jnp.einsum('bse,ed->bsd', jnp.concatenate([sb_y, gla_y], axis=-1), w_out)
    return x + rmsnorm(y, post_norm_w)


def setup_inputs(seed: int = 0) -> dict:
    key = jax.random.key(seed)
    ks = jax.random.split(key, 10)
    f32 = jnp.float32
    x = jax.random.normal(ks[0], (BATCH, SEQ, D_MODEL), f32)
    pre_norm_w = 1.0 + 0.02 * jax.random.normal(ks[1], (DEPTH, D_MODEL), f32)
    w_in = jax.random.normal(ks[2], (DEPTH, D_MODEL, IN_PROJ_WIDTH), f32) * D_MODEL ** -0.5
    w_alpha2 = jax.random.normal(ks[3], (DEPTH, GATE_RANK, GLA_KEY_WIDTH), f32) * GATE_RANK ** -0.5
    b_alpha2 = 0.1 * jax.random.normal(ks[4], (DEPTH, GLA_KEY_WIDTH), f32)
    sb_norm_w = 1.0 + 0.02 * jax.random.normal(ks[5], (DEPTH, SB_WIDTH), f32)
    gla_norm_w = 1.0 + 0.02 * jax.random.normal(ks[6], (DEPTH, GLA_WIDTH), f32)
    w_out = jax.random.normal(ks[7], (DEPTH, D_INNER, D_MODEL), f32) * D_INNER ** -0.5
    post_norm_w = 1.0 + 0.02 * jax.random.normal(ks[8], (DEPTH, D_MODEL), f32)
    return {"x": x, "pre_norm_w": pre_norm_w, "w_in": w_in, "w_alpha2": w_alpha2,
            "b_alpha2": b_alpha2, "sb_norm_w": sb_norm_w, "gla_norm_w": gla_norm_w,
            "w_out": w_out, "post_norm_w": post_norm_w}


def reference(x, pre_norm_w, w_in, w_alpha2, b_alpha2, sb_norm_w, gla_norm_w, w_out, post_norm_w):
    for layer in range(DEPTH):
        x = hybrid_layer(x, pre_norm_w[layer], w_in[layer], w_alpha2[layer], b_alpha2[layer],
                         sb_norm_w[layer], gla_norm_w[layer], w_out[layer], post_norm_w[layer])
    return x
```

```cpp
#include <hip/hip_runtime.h>
#include <cstdio>
#include <cstdint>
namespace pg8 {
#define PG8_LAS __attribute__((address_space(3)))
typedef unsigned short bf16_t;
typedef short bf16x8 __attribute__((ext_vector_type(8)));
typedef float f32x4 __attribute__((ext_vector_type(4)));
typedef unsigned u32x4 __attribute__((ext_vector_type(4)));
constexpr int BM = 256, BK = 64, HALF = 128, HTB = HALF * BK * 2  , STAGE_BYTES = 8 * HTB, NXCD = 8, WGM = 8;

__host__ __device__ __forceinline__ int lds_byte(int r, int c) { const int st = (r >> 4) * 2 + (c >> 5), rr = r & 15, cc = c & 31, ob = rr * 64 + cc * 2; return st * 1024 + (ob ^ (((ob >> 9) & 1) << 5)); }
__host__ __device__ __forceinline__ void stage_rc(int b, int& R, int& C) { const int st = b / 1024, sb = b % 1024, swz = sb ^ (((sb >> 9) & 1) << 5); R = (st >> 1) * 16 + swz / 64; C = (st & 1) * 32 + (swz % 64) / 2; }
__host__ __device__ __forceinline__ int perm32(int rho) { const int n = rho >> 4, i = rho & 15; return 8 * (i >> 2) + 4 * n + (i & 3); }

struct Unit { int pm, pn; };
struct Gemm { const bf16_t* A; const bf16_t* Bt; int M, N, K; };

struct StaticOrder {
    int nM, nN, nwg, G, c;
    __host__ __device__ void init(int M, int N, int G_, int c_) { nM = M / BM; nN = N / BM; nwg = nM * nN; G = G_; c = c_; }
    __host__ __device__ bool next(int i, Unit& u) const {
        const long L = (long)i * G + c; if (L >= nwg) return false;
        int wgid = (int)L; { const int q = nwg / NXCD, r = nwg % NXCD, xcd = wgid % NXCD, off = wgid / NXCD; wgid = (xcd < r ? xcd * (q + 1) : r * (q + 1) + (xcd - r) * q) + off; }
        const int nig = WGM * nN, gid = wgid / nig, fm = gid * WGM, gsz = (nM - fm) < WGM ? (nM - fm) : WGM;
        u.pm = fm + ((wgid % nig) % gsz); u.pn = (wgid % nig) / gsz; return true;
    }
    __device__ __forceinline__ void a_ready(const Unit&) const {}
    __device__ __forceinline__ void done(const Unit&) const {}
};

__device__ __forceinline__ unsigned cvt_pk_bf16(float lo, float hi) { unsigned r; asm volatile("v_cvt_pk_bf16_f32 %0, %1, %2" : "=v"(r) : "v"(lo), "v"(hi)); return r; }

struct EpiProj {
    static constexpr bool PERM = true, AFTER_DRAIN = false;
    bf16_t* P5; bf16_t* YG; const float* rs;
    __device__ __forceinline__ void operator()(const f32x4 (&acc)[2][2][4][2], const Unit& u, int wr, int wc, int fr, int fq) const {
        const int row0 = u.pm * BM + wr * 64 + fr; const int pn = u.pn;
        bf16_t* base; int ldc, colt;
        if (pn < 20) { base = P5; ldc = 5120; colt = pn * BM; } else { base = YG; ldc = 2048; colt = (pn - 20) * BM; }
        const float qs = (pn < 4 || pn == 12 || pn == 13) ? 0.08838834764831845f : 1.0f;
        const int col0 = colt + wc * 32 + 8 * fq;
#pragma unroll
        for (int ai = 0; ai < 2; ++ai)
#pragma unroll
            for (int m = 0; m < 4; ++m) { const int row = row0 + ai * HALF + m * 16; const float sc = rs[row] * qs; bf16_t* rowp = base + (size_t)row * ldc + col0;
#pragma unroll
                for (int bj = 0; bj < 2; ++bj) { const f32x4 v0 = acc[ai][bj][m][0] * sc, v1 = acc[ai][bj][m][1] * sc;
                    u32x4 w; w.x = cvt_pk_bf16(v0[0], v0[1]); w.y = cvt_pk_bf16(v0[2], v0[3]); w.z = cvt_pk_bf16(v1[0], v1[1]); w.w = cvt_pk_bf16(v1[2], v1[3]);
                    *(u32x4*)(rowp + bj * HALF) = w; } }
    }
};

struct EpiF32 {
    static constexpr bool PERM = false, AFTER_DRAIN = false;
    float* C; int ldc;
    __device__ __forceinline__ void operator()(const f32x4 (&acc)[2][2][4][2], const Unit& u, int wr, int wc, int fr, int fq) const {
        const int row0 = u.pm * BM + wr * 64 + fr, col0 = u.pn * BM + wc * 32 + 4 * fq;
#pragma unroll
        for (int ai = 0; ai < 2; ++ai)
#pragma unroll
            for (int m = 0; m < 4; ++m) { float* rowp = C + (size_t)(row0 + ai * HALF + m * 16) * ldc + col0;
#pragma unroll
                for (int bj = 0; bj < 2; ++bj)
#pragma unroll
                    for (int n = 0; n < 2; ++n) *(f32x4*)(rowp + bj * HALF + n * 16) = acc[ai][bj][m][n]; }
    }
};

template <class Epi, class Sched, bool ALIGN_EPI = false, bool SP2 = false>
__device__ __forceinline__ void gemm_phase(PG8_LAS unsigned char* lds, const Gemm g, const Sched& S, const Epi& E) {
    const int tid = threadIdx.x, wid = __builtin_amdgcn_readfirstlane(tid >> 6), lane = tid & 63, wr = wid >> 2, wc = wid & 3, fr = lane & 15, fq = lane >> 4;
    const int K = g.K, nt = K / BK;
    unsigned voffA[2], voffB[2];
#pragma unroll
    for (int i = 0; i < 2; ++i) { int R, C; stage_rc(tid * 16 + i * 8192, R, C); const int Rb = Epi::PERM ? ((R & ~31) + perm32(R & 31)) : R;
        voffA[i] = (unsigned)(R * K + C) * 2u; voffB[i] = (unsigned)(Rb * K + C) * 2u; }
    const size_t kstep = (size_t)(BK * 2);
    const size_t hstep = (size_t)HALF * K * 2;
    const size_t tstep = 2 * hstep;
    const unsigned ldsw = (unsigned)wid * 1024u;
    const int aoff = lds_byte(wr * 64 + fr, fq * 8), boff = lds_byte(wc * 32 + fr, fq * 8);
#define PG8_SA(b, h) (((b) * 2 + (h)) * HTB)
#define PG8_SB(b, h) ((4 + (b) * 2 + (h)) * HTB)
#define PG8_STAGE(bufoff, gbase, voff) do { _Pragma("unroll") for (int _i = 0; _i < 2; ++_i) \
        __builtin_amdgcn_global_load_lds((const unsigned*)((const char*)(gbase) + (voff)[_i]), (PG8_LAS unsigned*)(lds + (bufoff) + ldsw + _i * 8192), 16, 0, 0); } while (0)
#define PG8_LDA(dst, b, h) do { _Pragma("unroll") for (int m = 0; m < 4; ++m) _Pragma("unroll") for (int k = 0; k < 2; ++k) dst[m][k] = *(const PG8_LAS bf16x8*)(lds + PG8_SA(b, h) + aoff + m * 2048 + k * 1024); } while (0)
#define PG8_LDB(dst, b, h) do { _Pragma("unroll") for (int n = 0; n < 2; ++n) _Pragma("unroll") for (int k = 0; k < 2; ++k) dst[n][k] = *(const PG8_LAS bf16x8*)(lds + PG8_SB(b, h) + boff + n * 2048 + k * 1024); } while (0)
#define PG8_MMA(ai, bj, At, Bt) do { __builtin_amdgcn_s_setprio(1); _Pragma("unroll") for (int m = 0; m < 4; ++m) _Pragma("unroll") for (int n = 0; n < 2; ++n) _Pragma("unroll") for (int k = 0; k < 2; ++k) \
        acc[ai][bj][m][n] = __builtin_amdgcn_mfma_f32_16x16x32_bf16(Bt[n][k], At[m][k], acc[ai][bj][m][n], 0, 0, 0); __builtin_amdgcn_s_setprio(0); } while (0)
#define PG8_WAIT_V(n) asm volatile("s_waitcnt vmcnt(" #n ")" ::: "memory")
#define PG8_WAIT_L(n) asm volatile("s_waitcnt lgkmcnt(" #n ")" ::: "memory")
#define PG8_BAR __builtin_amdgcn_s_barrier()
#define PG8_SCHED __builtin_amdgcn_sched_barrier(0)
    Unit cur, nxt; int ui = 0;
    if (!S.next(0, cur)) return;
    f32x4 acc[2][2][4][2];
#pragma unroll
    for (int a = 0; a < 2; ++a)
#pragma unroll
        for (int b = 0; b < 2; ++b)
#pragma unroll
            for (int m = 0; m < 4; ++m)
#pragma unroll
                for (int n = 0; n < 2; ++n) acc[a][b][m][n] = (f32x4){0.f, 0.f, 0.f, 0.f};
    bf16x8 At[4][2], B0[2][2], B1[2][2];
    const char* cA = (const char*)g.A + (size_t)cur.pm * tstep; const char* cB = (const char*)g.Bt + (size_t)cur.pn * tstep;
    S.a_ready(cur);
    if constexpr (SP2) {
        PG8_STAGE(PG8_SB(0, 0), cB, voffB); PG8_STAGE(PG8_SB(0, 1), cB + hstep, voffB); PG8_STAGE(PG8_SA(0, 0), cA, voffA); PG8_STAGE(PG8_SA(0, 1), cA + hstep, voffA);
        if (wr == 1) PG8_BAR;
        PG8_WAIT_V(2); PG8_BAR;
        PG8_STAGE(PG8_SB(1, 0), cB + kstep, voffB); PG8_STAGE(PG8_SA(1, 0), cA + kstep, voffA); PG8_STAGE(PG8_SB(1, 1), cB + hstep + kstep, voffB);
        PG8_WAIT_V(6); PG8_BAR;
    } else {
        PG8_STAGE(PG8_SB(0, 0), cB, voffB); PG8_STAGE(PG8_SA(0, 0), cA, voffA); PG8_STAGE(PG8_SB(0, 1), cB + hstep, voffB); PG8_STAGE(PG8_SA(0, 1), cA + hstep, voffA);
        if (wr == 1) PG8_BAR;
        PG8_WAIT_V(4); PG8_BAR;
        PG8_STAGE(PG8_SB(1, 0), cB + kstep, voffB); PG8_STAGE(PG8_SA(1, 0), cA + kstep, voffA); PG8_STAGE(PG8_SB(1, 1), cB + hstep + kstep, voffB);
        PG8_WAIT_V(6); PG8_BAR;
    }
    for (;;) {
        const bool has_next = S.next(ui + 1, nxt);
        const char* nA = has_next ? (const char*)g.A + (size_t)nxt.pm * tstep : cA; const char* nB = has_next ? (const char*)g.Bt + (size_t)nxt.pn * tstep : cB;
        for (int t = 0; t < nt; t += 2) {
            const bool last = (t == nt - 2);
            const char* a1 = cA + (size_t)(t + 1) * kstep;
            const char* a2 = last ? nA : cA + (size_t)(t + 2) * kstep; const char* b2 = last ? nB : cB + (size_t)(t + 2) * kstep;
            const char* a3 = a2 + kstep; const char* b3 = b2 + kstep;
            if (last && has_next) S.a_ready(nxt);
            if constexpr (SP2) {
            PG8_LDB(B0, 0, 0); PG8_LDB(B1, 0, 1); PG8_SCHED; PG8_LDA(At, 0, 0); PG8_STAGE(PG8_SA(1, 1), a1 + hstep, voffA);
            PG8_WAIT_V(8); PG8_WAIT_L(0); PG8_BAR; PG8_MMA(0, 0, At, B0); PG8_MMA(0, 1, At, B1); PG8_BAR; PG8_SCHED;
            PG8_LDA(At, 0, 1); PG8_STAGE(PG8_SB(0, 0), b2, voffB); PG8_STAGE(PG8_SB(0, 1), b2 + hstep, voffB); PG8_STAGE(PG8_SA(0, 0), a2, voffA);
            PG8_WAIT_V(8); PG8_WAIT_L(0); PG8_BAR; PG8_MMA(1, 0, At, B0); PG8_MMA(1, 1, At, B1); PG8_BAR; PG8_SCHED;
            PG8_LDB(B0, 1, 0); PG8_LDB(B1, 1, 1); PG8_SCHED; PG8_LDA(At, 1, 0); PG8_STAGE(PG8_SA(0, 1), a2 + hstep, voffA);
            PG8_WAIT_V(8); PG8_WAIT_L(0); PG8_BAR; PG8_MMA(0, 0, At, B0); PG8_MMA(0, 1, At, B1); PG8_BAR; PG8_SCHED;
            PG8_LDA(At, 1, 1); PG8_STAGE(PG8_SB(1, 0), b3, voffB); PG8_STAGE(PG8_SB(1, 1), b3 + hstep, voffB); PG8_STAGE(PG8_SA(1, 0), a3, voffA);
            PG8_WAIT_V(8); PG8_WAIT_L(0); PG8_BAR; PG8_MMA(1, 0, At, B0); PG8_MMA(1, 1, At, B1); PG8_BAR; PG8_SCHED;
            } else {
            PG8_LDB(B0, 0, 0); PG8_SCHED; PG8_LDA(At, 0, 0); PG8_STAGE(PG8_SA(1, 1), a1 + hstep, voffA);
            PG8_WAIT_L(8); PG8_BAR; PG8_WAIT_L(0); PG8_MMA(0, 0, At, B0); PG8_BAR; PG8_SCHED;
            PG8_LDB(B1, 0, 1); PG8_STAGE(PG8_SB(0, 0), b2, voffB);
            PG8_BAR; PG8_WAIT_L(0); PG8_MMA(0, 1, At, B1); PG8_BAR;
            PG8_LDA(At, 0, 1); PG8_STAGE(PG8_SA(0, 0), a2, voffA);
            PG8_BAR; PG8_WAIT_L(0); PG8_MMA(1, 0, At, B0); PG8_BAR; PG8_SCHED;
            PG8_STAGE(PG8_SB(0, 1), b2 + hstep, voffB);
            PG8_WAIT_V(6); PG8_BAR; PG8_MMA(1, 1, At, B1); PG8_BAR;
            PG8_LDB(B0, 1, 0); PG8_SCHED; PG8_LDA(At, 1, 0); PG8_STAGE(PG8_SA(0, 1), a2 + hstep, voffA);
            PG8_WAIT_L(8); PG8_BAR; PG8_WAIT_L(0); PG8_MMA(0, 0, At, B0); PG8_BAR; PG8_SCHED;
            PG8_LDB(B1, 1, 1); PG8_STAGE(PG8_SB(1, 0), b3, voffB);
            PG8_BAR; PG8_WAIT_L(0); PG8_MMA(0, 1, At, B1); PG8_BAR;
            PG8_LDA(At, 1, 1); PG8_STAGE(PG8_SA(1, 0), a3, voffA);
            PG8_BAR; PG8_WAIT_L(0); PG8_MMA(1, 0, At, B0); PG8_BAR; PG8_SCHED;
            PG8_STAGE(PG8_SB(1, 1), b3 + hstep, voffB);
            PG8_WAIT_V(6); PG8_BAR; PG8_MMA(1, 1, At, B1); PG8_BAR;
            }
        }
        if constexpr (ALIGN_EPI) { if (wr == 0) PG8_BAR; }
        if constexpr (!Epi::AFTER_DRAIN) { E(acc, cur, wr, wc, fr, fq); S.done(cur); }
        if (!has_next) break;
#pragma unroll
        for (int a = 0; a < 2; ++a)
#pragma unroll
            for (int b = 0; b < 2; ++b)
#pragma unroll
                for (int m = 0; m < 4; ++m)
#pragma unroll
                    for (int n = 0; n < 2; ++n) acc[a][b][m][n] = (f32x4){0.f, 0.f, 0.f, 0.f};
        cur = nxt; cA = nA; cB = nB; ++ui;
        if constexpr (ALIGN_EPI) { if (wr == 1) PG8_BAR; }
    }
    PG8_WAIT_V(0);
    if constexpr (!ALIGN_EPI) { if (wr == 0) PG8_BAR; }
    PG8_BAR;
    if constexpr (Epi::AFTER_DRAIN) { E.fused(acc, cur, wr, wc, fr, fq, lds, wid, lane); S.done(cur); }
#undef PG8_SA
#undef PG8_SB
#undef PG8_STAGE
#undef PG8_LDA
#undef PG8_LDB
#undef PG8_MMA
#undef PG8_WAIT_V
#undef PG8_WAIT_L
#undef PG8_BAR
#undef PG8_SCHED
}
}
#define GAS __attribute__((address_space(1)))
#define LAS __attribute__((address_space(3)))
typedef unsigned short bf16;
typedef unsigned v4u __attribute__((ext_vector_type(4)));
typedef float f32x4 __attribute__((ext_vector_type(4)));
typedef short bf16x8 __attribute__((ext_vector_type(8)));
typedef GAS unsigned gu32;
typedef GAS unsigned long long gu64;
#define RLX_AGENT __ATOMIC_RELAXED, __HIP_MEMORY_SCOPE_AGENT
#define LDS_WAIT() asm volatile("s_waitcnt lgkmcnt(0)" ::: "memory")
#define VM_WAIT() asm volatile("s_waitcnt vmcnt(0)" ::: "memory")
__device__ __forceinline__ unsigned long long rt() { return __builtin_amdgcn_s_memrealtime(); }
__device__ __forceinline__ unsigned f2bf(float f) { unsigned u = __builtin_bit_cast(unsigned, f); return (u + 0x7fffu + ((u >> 16) & 1u)) >> 16; }
__device__ __forceinline__ unsigned pk2(float lo, float hi) { return f2bf(lo) | (f2bf(hi) << 16); }

#define XB_TMO      128
#define XB_XCNT(j)  (256  + 64 * (j))
#define XB_XSUB(j)  (1280 + 64 * (j))
#define XB_XGEN(j)  (2304 + 64 * (j))
#define XB_TOP      3328
#define XB_TOPGEN   3392
#define XCD_BAR_WORDS 3456
#define XB_SPIN_CAP (1u << 18)

__device__ __forceinline__ unsigned xb_ld(unsigned* p)              { return __hip_atomic_load(p, __ATOMIC_RELAXED, __HIP_MEMORY_SCOPE_AGENT); }
__device__ __forceinline__ unsigned xb_add(unsigned* p, unsigned v) { return __hip_atomic_fetch_add(p, v, __ATOMIC_RELAXED, __HIP_MEMORY_SCOPE_AGENT); }
__device__ __forceinline__ unsigned xb_xcc_id() { return (unsigned)__builtin_amdgcn_s_getreg((3 << 11) | 20) & 0xFu; }
#define XB_SPIN(cond, bar) do { unsigned _sp = 0; while (cond) { __builtin_amdgcn_s_sleep(1); \
    if ((++_sp & 255u) == 0u) { if (xb_ld(&(bar)[XB_TMO])) break; if (_sp > XB_SPIN_CAP) { atomicAdd(&(bar)[XB_TMO], 1u); break; } } } } while (0)

struct XcdBarrier {
    unsigned* bar; unsigned x;
    volatile LAS unsigned* st;
};

__device__ __forceinline__ XcdBarrier xcd_barrier_post(unsigned* bar, volatile LAS unsigned* st) {
    XcdBarrier b; b.bar = bar; b.x = xb_xcc_id(); b.st = st;
    if (threadIdx.x == 0) (void)xb_add(&bar[XB_XCNT(b.x)], 1u);
    return b;
}
__device__ __forceinline__ void xcd_barrier_complete(unsigned* bar, unsigned x, unsigned& nloc, unsigned& nx) {
    const unsigned G = gridDim.x * gridDim.y * gridDim.z;
    unsigned sum, cnt, mine, sp = 0u;
    for (;;) {
        sum = 0u; cnt = 0u; mine = 0u;
#pragma unroll
        for (unsigned j = 0; j < 16; ++j) { const unsigned c = xb_ld(&bar[XB_XCNT(j)]); sum += c; cnt += (c > 0u) ? 1u : 0u; mine = (j == x) ? c : mine; }
        if (sum == G) break;
        __builtin_amdgcn_s_sleep(1);
        if ((++sp & 255u) == 0u) { if (xb_ld(&bar[XB_TMO])) break; if (sp > XB_SPIN_CAP) { atomicAdd(&bar[XB_TMO], 1u); break; } }
    }
    nloc = mine > 0u ? mine : 1u; nx = cnt > 0u ? cnt : 1u;
}

__device__ __forceinline__ void xcd_barrier(const XcdBarrier& b) {
    asm volatile("s_waitcnt vmcnt(0)" ::: "memory");
    __syncthreads();
    if (threadIdx.x == 0) {
        unsigned* bar = b.bar;
        __builtin_amdgcn_s_waitcnt(0);
        unsigned nloc = b.st[0], nx = b.st[1];
        if (nloc == 0u) { xcd_barrier_complete(bar, b.x, nloc, nx); b.st[0] = nloc; b.st[1] = nx; }
        const unsigned old = xb_add(&bar[XB_XSUB(b.x)], 1u);
        const unsigned gen = old / nloc;
        if (old + 1u == (gen + 1u) * nloc) {
            __builtin_amdgcn_fence(__ATOMIC_RELEASE, "agent");
            asm volatile("s_waitcnt vmcnt(0)" ::: "memory");
            const unsigned og = xb_add(&bar[XB_TOP], 1u);
            const unsigned tg = og / nx;
            if (og + 1u == (tg + 1u) * nx) xb_add(&bar[XB_TOPGEN], 1u);
            else XB_SPIN(xb_ld(&bar[XB_TOPGEN]) == tg, bar);
            __builtin_amdgcn_fence(__ATOMIC_ACQUIRE, "agent");
            xb_add(&bar[XB_XGEN(b.x)], 1u);
            asm volatile("s_waitcnt vmcnt(0)" ::: "memory");
        } else {
            XB_SPIN(xb_ld(&bar[XB_XGEN(b.x)]) == gen, bar);
            __builtin_amdgcn_fence(__ATOMIC_ACQUIRE, "agent");
            asm volatile("s_waitcnt vmcnt(0)" ::: "memory");
        }
    }
    __syncthreads();
}

constexpr int NWAVES = 8;
constexpr int BATCH = 4, SEQ = 8192, D = 1024, M = BATCH * SEQ;
constexpr int NIN = 7184, NPROJ = 7168;
constexpr int P5W = 5120, YGW = 2048;
constexpr int P5_SBQ = 0, P5_SBK = 1024, P5_SBV = 2048, P5_GQ = 3072, P5_GK = 3584, P5_GV = 4096;
constexpr int SBH = 8, SBD = 128, GH = 4, GDK = 128, GDV = 256, RANK = 16;
constexpr float NORM_EPS = 1e-6f;

constexpr size_t MiB = 1u << 20;
constexpr size_t WS_CTL = 0, CTL_ZERO_BYTES = 1 * MiB;
constexpr size_t WS_WIN = 2 * MiB;
constexpr size_t WS_WOUT = 16 * MiB;
constexpr size_t WS_RS = 20 * MiB;
constexpr size_t WS_LR = 21 * MiB;
constexpr size_t WS_P5 = 24 * MiB;
constexpr size_t WS_YG = 344 * MiB;
constexpr size_t WS_END = 472 * MiB;
constexpr int CW_BAR = 4096;

constexpr int RING_OFF = 0, RING_BYTES = 131072;
constexpr int LDSCTL_OFF = RING_BYTES, MISC_OFF = LDSCTL_OFF + 320;
constexpr int LDS_BYTES = 147456;

struct Frame {
    LAS unsigned char* lds;
    volatile LAS unsigned* MISC;
    gu32* ctl;
    int tid, lane, wave;
    int vcu, G;
};

__device__ __forceinline__ float wave_sum(float v) {
#pragma unroll
    for (int o = 1; o < 64; o <<= 1) v += __shfl_xor(v, o);
    return v;
}
__device__ __forceinline__ float bf2f(unsigned short b) { return __uint_as_float(((unsigned)b) << 16); }

__device__ __forceinline__ void p0_transpose_item(const float* W, int ldw, int n_src0, const float* kscale, bf16* WT, int K, int n_dst0, int k0, LAS float* scr, int lane) {
#pragma unroll 8
    for (int i = 0; i < 32; ++i) { const int kk = 2 * i + (lane >> 5); float v = W[(size_t)(k0 + kk) * ldw + n_src0 + (lane & 31)]; if (kscale) v *= kscale[k0 + kk]; scr[kk * 33 + (lane & 31)] = v; }
    LDS_WAIT(); asm volatile("" ::: "memory");
    const int c = lane & 7;
#pragma unroll
    for (int j = 0; j < 4; ++j) { const int n = (lane >> 3) + 8 * j; const LAS float* s = scr + (8 * c) * 33 + n;
        v4u o; o.x = pk2(s[0 * 33], s[1 * 33]); o.y = pk2(s[2 * 33], s[3 * 33]); o.z = pk2(s[4 * 33], s[5 * 33]); o.w = pk2(s[6 * 33], s[7 * 33]);
        *(GAS v4u*)(WT + (size_t)(n_dst0 + n) * K + k0 + 8 * c) = o; }
    LDS_WAIT(); asm volatile("" ::: "memory");
}
__device__ __forceinline__ int win_src_col(int n) { return n < 3072 ? n : (n < 5120 ? n + 1024 : (n < 6144 ? n - 2048 : n)); }

struct Args { const float* in[9]; float* out; unsigned char* ws; int ph_lo, ph_hi, li, pad; };

__device__ __forceinline__ void p0_prologue(Frame& F, const Args& a) {
    const float* x = a.in[0]; const float* pre_w = a.in[1]; const float* w_in = a.in[2]; const float* w_out = a.in[7];
    bf16* WinT = (bf16*)(a.ws + WS_WIN); bf16* WoutT = (bf16*)(a.ws + WS_WOUT);
    float* RS = (float*)(a.ws + WS_RS); float* LR = (float*)(a.ws + WS_LR);
    bf16* XB = (bf16*)a.out;
    const int gw = F.vcu * NWAVES + F.wave, NGW = F.G * NWAVES;
    {
        LAS float* scr = (LAS float*)(F.lds + RING_OFF + F.wave * 16384);
        constexpr int I_IN = (D / 64) * (NPROJ / 32), I_OUT = (2048 / 64) * (D / 32);
        for (int it = gw; it < I_IN + I_OUT; it += NGW) {
            if (it < I_IN) { const int nb = it % (NPROJ / 32), kb = it / (NPROJ / 32); p0_transpose_item(w_in, NIN, win_src_col(32 * nb), pre_w, WinT, D, 32 * nb, 64 * kb, scr, F.lane); }
            else { const int r = it - I_IN, nb = r % (D / 32), kb = r / (D / 32); p0_transpose_item(w_out, D, 32 * nb, nullptr, WoutT, 2048, 32 * nb, 64 * kb, scr, F.lane); }
        }
    }
    __syncthreads();
    LAS float* WL = (LAS float*)(F.lds + RING_OFF);
    for (int k = F.tid; k < D; k += NWAVES * 64) {
        const float g = pre_w[k]; const f32x4* src = (const f32x4*)(w_in + (size_t)k * NIN + NPROJ);
#pragma unroll
        for (int q = 0; q < 4; ++q) { const f32x4 w = src[q]; WL[(4 * q + 0) * D + k] = w.x * g; WL[(4 * q + 1) * D + k] = w.y * g; WL[(4 * q + 2) * D + k] = w.z * g; WL[(4 * q + 3) * D + k] = w.w * g; }
    }
    __syncthreads();
    for (int m = gw; m < M; m += NGW) {
        const GAS f32x4* xr = (const GAS f32x4*)(x + (size_t)m * D) + F.lane;
        f32x4 v[4]; float s = 0.f;
#pragma unroll
        for (int j = 0; j < 4; ++j) { v[j] = xr[64 * j]; s += (v[j].x * v[j].x + v[j].y * v[j].y) + (v[j].z * v[j].z + v[j].w * v[j].w); }
        const float rstd = 1.0f / sqrtf(wave_sum(s) * (1.f / D) + NORM_EPS);
        GAS unsigned long long* o8 = (GAS unsigned long long*)(XB + (size_t)m * D) + F.lane;
#pragma unroll
        for (int j = 0; j < 4; ++j) o8[64 * j] = (unsigned long long)pk2(v[j].x, v[j].y) | ((unsigned long long)pk2(v[j].z, v[j].w) << 32);
        float p[16];
#pragma unroll
        for (int n = 0; n < 16; ++n) { float acc = 0.f;
#pragma unroll
            for (int j = 0; j < 4; ++j) { const f32x4 w = *(const LAS f32x4*)(WL + n * D + 4 * F.lane + 256 * j); acc += (v[j].x * w.x + v[j].y * w.y) + (v[j].z * w.z + v[j].w * w.w); }
            p[n] = acc; if (n & 1) asm volatile("" ::: "memory"); }
        float q8[8], q4[4], q2[2], q1;
        { const bool hi = (F.lane & 32) != 0;
#pragma unroll
          for (int i = 0; i < 8; ++i) { const float keep = hi ? p[i + 8] : p[i], send = hi ? p[i] : p[i + 8]; q8[i] = keep + __shfl_xor(send, 32); } }
        { const bool hi = (F.lane & 16) != 0;
#pragma unroll
          for (int i = 0; i < 4; ++i) { const float keep = hi ? q8[i + 4] : q8[i], send = hi ? q8[i] : q8[i + 4]; q4[i] = keep + __shfl_xor(send, 16); } }
        { const bool hi = (F.lane & 8) != 0;
#pragma unroll
          for (int i = 0; i < 2; ++i) { const float keep = hi ? q4[i + 2] : q4[i], send = hi ? q4[i] : q4[i + 2]; q2[i] = keep + __shfl_xor(send, 8); } }
        { const bool hi = (F.lane & 4) != 0; const float keep = hi ? q2[1] : q2[0], send = hi ? q2[0] : q2[1]; q1 = keep + __shfl_xor(send, 4); }
        q1 += __shfl_xor(q1, 2); q1 += __shfl_xor(q1, 1);
        if ((F.lane & 3) == 0) { const int n = ((F.lane >> 5) & 1) * 8 + ((F.lane >> 4) & 1) * 4 + ((F.lane >> 3) & 1) * 2 + ((F.lane >> 2) & 1); LR[(size_t)m * RANK + n] = q1 * rstd; }
        if (F.lane == 0) RS[m] = rstd;
    }
}

__device__ __forceinline__ void p4_final(Frame& F, const Args& a) {
    const float* x = a.in[0]; const float* post_w = a.in[8]; float* out = a.out;
    const int gw = F.vcu * NWAVES + F.wave, NGW = F.G * NWAVES;
    f32x4 g[4];
#pragma unroll
    for (int j = 0; j < 4; ++j) g[j] = *((const f32x4*)post_w + F.lane + 64 * j);
    for (int m = gw; m < M; m += NGW) {
        GAS f32x4* yr = (GAS f32x4*)(out + (size_t)m * D) + F.lane; const GAS f32x4* xr = (const GAS f32x4*)(x + (size_t)m * D) + F.lane;
        f32x4 v[4], xv[4]; float s = 0.f;
#pragma unroll
        for (int j = 0; j < 4; ++j) { v[j] = yr[64 * j]; xv[j] = xr[64 * j]; s += (v[j].x * v[j].x + v[j].y * v[j].y) + (v[j].z * v[j].z + v[j].w * v[j].w); }
        const float rstd = 1.0f / sqrtf(wave_sum(s) * (1.f / D) + NORM_EPS);
#pragma unroll
        for (int j = 0; j < 4; ++j) yr[64 * j] = xv[j] + (v[j] * rstd) * g[j];
    }
}

__global__ void __launch_bounds__(NWAVES * 64, 2) hybrid_fwd(Args args) {
    extern __shared__ __attribute__((aligned(16))) unsigned char lds[];
    Frame F;
    F.lds = (LAS unsigned char*)lds;
    F.MISC = (volatile LAS unsigned*)(F.lds + MISC_OFF);
    F.tid = threadIdx.x; F.lane = F.tid & 63; F.wave = __builtin_amdgcn_readfirstlane(F.tid >> 6);
    F.G = gridDim.x; { const int bx = blockIdx.x; F.vcu = (F.G % 8 == 0) ? (bx % 8) * (F.G / 8) + bx / 8 : bx; }
    unsigned char* ws = args.ws;
    F.ctl = (gu32*)(ws + WS_CTL);
    for (int u = F.tid; u < (LDS_BYTES - LDSCTL_OFF) / 4; u += NWAVES * 64) ((LAS unsigned*)(F.lds + LDSCTL_OFF))[u] = 0u;
    __syncthreads();
    XcdBarrier bar = xcd_barrier_post((unsigned*)(F.ctl + CW_BAR) + args.li * XCD_BAR_WORDS, F.MISC + 8);
    const int lo = args.ph_lo, hi = args.ph_hi;
#define IN(k) (lo <= (k) && (k) < hi)
#define BOTH(k) (IN(k) && IN((k) + 1))

    if (IN(0)) { p0_prologue(F, args); if (BOTH(0)) xcd_barrier(bar); }

    if (IN(1)) {
        pg8::Gemm g{(const pg8::bf16_t*)args.out, (const pg8::bf16_t*)(ws + WS_WIN), M, NPROJ, D}; pg8::StaticOrder S; S.init(M, NPROJ, F.G, (int)blockIdx.x);
        pg8::EpiProj E{(pg8::bf16_t*)(ws + WS_P5), (pg8::bf16_t*)(ws + WS_YG), (const float*)(ws + WS_RS)};
        pg8::gemm_phase<pg8::EpiProj, pg8::StaticOrder, true, true>(F.lds + RING_OFF, g, S, E);
        if (BOTH(1)) xcd_barrier(bar);
    }

    if (IN(3)) {
        pg8::Gemm g{(const pg8::bf16_t*)(ws + WS_YG), (const pg8::bf16_t*)(ws + WS_WOUT), M, D, 2048}; pg8::StaticOrder S; S.init(M, D, F.G, (int)blockIdx.x);
        pg8::EpiF32 E{args.out, D};
        pg8::gemm_phase<pg8::EpiF32, pg8::StaticOrder, true, true>(F.lds + RING_OFF, g, S, E);
        if (BOTH(3)) xcd_barrier(bar);
    }

    if (IN(4)) p4_final(F, args);
#undef IN
#undef BOTH
}

__device__ __forceinline__ float softplus_f(float z) { return fmaxf(z, 0.f) + log1pf(expf(-fabsf(z))); }

__global__ void __launch_bounds__(256) naive_sb(const bf16* __restrict__ P5, bf16* YG, const float* __restrict__ sb_norm_w) {
    __shared__ float qs[4][128];
    __shared__ float wsh[4][64];
    const int lane = threadIdx.x & 63, wv = threadIdx.x >> 6;
    const int nitem = BATCH * SBH * SEQ, nw = gridDim.x * 4;
    for (int item = blockIdx.x * 4 + wv; item < nitem; item += nw) {
        const int t = item % SEQ, h = (item / SEQ) % SBH, b = item / (SEQ * SBH);
        const size_t row = (size_t)b * SEQ + t;
        { const unsigned qq = *(const unsigned*)(P5 + row * P5W + P5_SBQ + h * SBD + 2 * lane); qs[wv][2 * lane] = bf2f(qq & 0xffff); qs[wv][2 * lane + 1] = bf2f(qq >> 16); }
        asm volatile("s_waitcnt lgkmcnt(0)" ::: "memory");
        float logsurv = 0.f, a0 = 0.f, a1 = 0.f;
        for (int shi = t - 1; shi >= 0; shi -= 64) {
            const int s = shi - lane; const bool valid = s >= 0;
            float z = 0.f;
            if (valid) { const uint4* kr = (const uint4*)(P5 + ((size_t)b * SEQ + s) * P5W + P5_SBK + h * SBD);
                for (int c = 0; c < 16; ++c) { const uint4 kk = kr[c]; const float* q = &qs[wv][8 * c];
                    z += bf2f(kk.x & 0xffff) * q[0] + bf2f(kk.x >> 16) * q[1] + bf2f(kk.y & 0xffff) * q[2] + bf2f(kk.y >> 16) * q[3]
                       + bf2f(kk.z & 0xffff) * q[4] + bf2f(kk.z >> 16) * q[5] + bf2f(kk.w & 0xffff) * q[6] + bf2f(kk.w >> 16) * q[7]; } }
            const float lf = valid ? -softplus_f(z) : 0.f;
            float incl = lf;
#pragma unroll
            for (int o = 1; o < 64; o <<= 1) { const float u = __shfl_up(incl, o); if (lane >= o) incl += u; }
            const float logw = (z + lf) + (incl - lf) + logsurv;
            const float w = valid ? expf(logw) : 0.f;
            wsh[wv][lane] = w;
            asm volatile("s_waitcnt lgkmcnt(0)" ::: "memory");
            const int nk = shi + 1 < 64 ? shi + 1 : 64;
            for (int j = 0; j < nk; ++j) { const float wj = wsh[wv][j];
                const unsigned vv = *(const unsigned*)(P5 + ((size_t)b * SEQ + (shi - j)) * P5W + P5_SBV + h * SBD + 2 * lane);
                a0 += wj * bf2f(vv & 0xffff); a1 += wj * bf2f(vv >> 16); }
            logsurv += __shfl(incl, 63);
            asm volatile("s_waitcnt lgkmcnt(0)" ::: "memory");
            if (logsurv < -110.f) break;
        }
        const float ss = wave_sum(a0 * a0 + a1 * a1);
        const float rstd = 1.0f / sqrtf(ss * (1.f / SBD) + NORM_EPS);
        bf16* yp = YG + row * YGW + h * SBD + 2 * lane;
        const unsigned gg = *(const unsigned*)yp; const float g0 = bf2f(gg & 0xffff), g1 = bf2f(gg >> 16);
        const float y0 = a0 * rstd * sb_norm_w[h * SBD + 2 * lane] * (g0 / (1.f + expf(-g0)));
        const float y1 = a1 * rstd * sb_norm_w[h * SBD + 2 * lane + 1] * (g1 / (1.f + expf(-g1)));
        *(unsigned*)yp = pk2(y0, y1);
    }
}

__global__ void __launch_bounds__(256) naive_decay(const float* __restrict__ LR, const float* __restrict__ w_alpha2, const float* __restrict__ b_alpha2, float* ADEC) {
    const size_t n = (size_t)M * 512;
    for (size_t i = (size_t)blockIdx.x * 256 + threadIdx.x; i < n; i += (size_t)gridDim.x * 256) {
        const int c = (int)(i % 512); const size_t row = i / 512;
        float lg = b_alpha2[c];
#pragma unroll
        for (int j = 0; j < RANK; ++j) lg += LR[row * RANK + j] * w_alpha2[j * 512 + c];
        const float ls = fminf(lg, 0.f) - log1pf(expf(-fabsf(lg)));
        ADEC[i] = expf(ls * (1.f / 16.f));
    }
}

__global__ void __launch_bounds__(512) naive_gla(const bf16* __restrict__ P5, bf16* YG, const float* __restrict__ ADEC, const float* __restrict__ gla_norm_w) {
    __shared__ float red[8];
    const int b = blockIdx.x / GH, h = blockIdx.x % GH;
    const int tid = threadIdx.x, dv = tid >> 1, kq = tid & 1, lane = tid & 63, wv = tid >> 6;
    float S[64];
#pragma unroll
    for (int i = 0; i < 64; ++i) S[i] = 0.f;
    const float gw = gla_norm_w[h * GDV + dv];
    for (int t = 0; t < SEQ; ++t) {
        const size_t row = (size_t)b * SEQ + t;
        const bf16* qp = P5 + row * P5W + P5_GQ + h * GDK + kq * 64;
        const bf16* kp = P5 + row * P5W + P5_GK + h * GDK + kq * 64;
        const float* ap = ADEC + row * 512 + h * GDK + kq * 64;
        const float v = bf2f(P5[row * P5W + P5_GV + h * GDV + dv]);
        float o = 0.f;
#pragma unroll
        for (int c = 0; c < 8; ++c) {
            const uint4 qq = *(const uint4*)(qp + 8 * c), kk = *(const uint4*)(kp + 8 * c);
            const float4 a0 = *(const float4*)(ap + 8 * c), a1 = *(const float4*)(ap + 8 * c + 4);
            float* s = &S[8 * c];
            s[0] = a0.x * s[0] + bf2f(kk.x & 0xffff) * v; o += bf2f(qq.x & 0xffff) * s[0];
            s[1] = a0.y * s[1] + bf2f(kk.x >> 16) * v;    o += bf2f(qq.x >> 16) * s[1];
            s[2] = a0.z * s[2] + bf2f(kk.y & 0xffff) * v; o += bf2f(qq.y & 0xffff) * s[2];
            s[3] = a0.w * s[3] + bf2f(kk.y >> 16) * v;    o += bf2f(qq.y >> 16) * s[3];
            s[4] = a1.x * s[4] + bf2f(kk.z & 0xffff) * v; o += bf2f(qq.z & 0xffff) * s[4];
            s[5] = a1.y * s[5] + bf2f(kk.z >> 16) * v;    o += bf2f(qq.z >> 16) * s[5];
            s[6] = a1.z * s[6] + bf2f(kk.w & 0xffff) * v; o += bf2f(qq.w & 0xffff) * s[6];
            s[7] = a1.w * s[7] + bf2f(kk.w >> 16) * v;    o += bf2f(qq.w >> 16) * s[7];
        }
        o += __shfl_xor(o, 1);
        float sq = (kq == 0) ? o * o : 0.f;
        sq = wave_sum(sq);
        if (lane == 0) red[wv] = sq;
        __syncthreads();
        const float tot = ((red[0] + red[1]) + (red[2] + red[3])) + ((red[4] + red[5]) + (red[6] + red[7]));
        __syncthreads();
        const float rstd = 1.0f / sqrtf(tot * (1.f / GDV) + NORM_EPS);
        if (kq == 0) { bf16* yp = YG + row * YGW + 1024 + h * GDV + dv; const float g = bf2f(*yp); *yp = (bf16)f2bf(o * rstd * gw * (g / (1.f + expf(-g)))); }
    }
}

extern "C" void kernel_launch(void* const* d_in, const int* in_sizes, int n_in, void* d_out, int out_size, void* d_ws, size_t ws_size, hipStream_t stream) {
    static int grid = 0;
    if (grid == 0) {
        if (n_in != 9 || in_sizes[0] != M * D || out_size != M * D || ws_size < WS_END) { fprintf(stderr, "kernel_launch: unexpected shapes (n_in %d, in0 %d, out %d, ws %zu)\n", n_in, n_in > 0 ? in_sizes[0] : -1, out_size, ws_size); grid = -1; return; }
        int dev = 0, cus = 0, per_cu = 0;
        if (hipGetDevice(&dev) != hipSuccess || hipDeviceGetAttribute(&cus, hipDeviceAttributeMultiprocessorCount, dev) != hipSuccess) { grid = -1; return; }
        if (hipFuncSetAttribute((const void*)hybrid_fwd, hipFuncAttributeMaxDynamicSharedMemorySize, LDS_BYTES) != hipSuccess) { fprintf(stderr, "kernel_launch: hipFuncSetAttribute failed\n"); grid = -1; return; }
        if (hipOccupancyMaxActiveBlocksPerMultiprocessor(&per_cu, (const void*)hybrid_fwd, NWAVES * 64, LDS_BYTES) != hipSuccess || per_cu < 1) { fprintf(stderr, "kernel_launch: occupancy query says %d blocks per CU\n", per_cu); grid = -1; (void)hipGetLastError(); return; }
        grid = cus;
    }
    if (grid < 0) return;
    (void)hipMemsetAsync((char*)d_ws + WS_CTL, 0, CTL_ZERO_BYTES, stream);
    Args a{};
    for (int i = 0; i < 9; ++i) a.in[i] = (const float*)d_in[i];
    a.out = (float*)d_out; a.ws = (unsigned char*)d_ws;
    a.ph_lo = 0; a.ph_hi = 2; a.li = 0;
    hipLaunchKernelGGL(hybrid_fwd, dim3(grid), dim3(NWAVES * 64), LDS_BYTES, stream, a);
    const bf16* P5 = (const bf16*)((char*)d_ws + WS_P5); bf16* YG = (bf16*)((char*)d_ws + WS_YG);
    hipLaunchKernelGGL(naive_sb, dim3(4096), dim3(256), 0, stream, P5, YG, (const float*)d_in[5]);
    hipLaunchKernelGGL(naive_decay, dim3(4096), dim3(256), 0, stream, (const float*)((char*)d_ws + WS_LR), (const float*)d_in[3], (const float*)d_in[4], (float*)d_out);
    hipLaunchKernelGGL(naive_gla, dim3(BATCH * GH), dim3(512), 0, stream, P5, YG, (const float*)d_out, (const float*)d_in[6]);
    a.ph_lo = 3; a.ph_hi = 5; a.li = 1;
    hipLaunchKernelGGL(hybrid_fwd, dim3(grid), dim3(NWAVES * 64), LDS_BYTES, stream, a);
}
```

```cpp
#include <hip/hip_runtime.h>
#include <cstdio>
#include <cstdint>
namespace pg8 {
#define PG8_LAS __attribute__((address_space(3)))
typedef unsigned short bf16_t;
typedef short bf16x8 __attribute__((ext_vector_type(8)));
typedef float f32x4 __attribute__((ext_vector_type(4)));
typedef unsigned u32x4 __attribute__((ext_vector_type(4)));
constexpr int BM = 256, BK = 64, HALF = 128, HTB = HALF * BK * 2  , STAGE_BYTES = 8 * HTB, NXCD = 8, WGM = 8;

__host__ __device__ __forceinline__ int lds_byte(int r, int c) { const int st = (r >> 4) * 2 + (c >> 5), rr = r & 15, cc = c & 31, ob = rr * 64 + cc * 2; return st * 1024 + (ob ^ (((ob >> 9) & 1) << 5)); }
__host__ __device__ __forceinline__ void stage_rc(int b, int& R, int& C) { const int st = b / 1024, sb = b % 1024, swz = sb ^ (((sb >> 9) & 1) << 5); R = (st >> 1) * 16 + swz / 64; C = (st & 1) * 32 + (swz % 64) / 2; }
__host__ __device__ __forceinline__ int perm32(int rho) { const int n = rho >> 4, i = rho & 15; return 8 * (i >> 2) + 4 * n + (i & 3); }

struct Unit { int pm, pn; };
struct Gemm { const bf16_t* A; const bf16_t* Bt; int M, N, K; };

struct StaticOrder {
    int nM, nN, nwg, G, c;
    __host__ __device__ void init(int M, int N, int G_, int c_) { nM = M / BM; nN = N / BM; nwg = nM * nN; G = G_; c = c_; }
    __host__ __device__ bool next(int i, Unit& u) const {
        const long L = (long)i * G + c; if (L >= nwg) return false;
        int wgid = (int)L; { const int q = nwg / NXCD, r = nwg % NXCD, xcd = wgid % NXCD, off = wgid / NXCD; wgid = (xcd < r ? xcd * (q + 1) : r * (q + 1) + (xcd - r) * q) + off; }
        const int nig = WGM * nN, gid = wgid / nig, fm = gid * WGM, gsz = (nM - fm) < WGM ? (nM - fm) : WGM;
        u.pm = fm + ((wgid % nig) % gsz); u.pn = (wgid % nig) / gsz; return true;
    }
    __device__ __forceinline__ void a_ready(const Unit&) const {}
    __device__ __forceinline__ void done(const Unit&) const {}
};

__device__ __forceinline__ unsigned cvt_pk_bf16(float lo, float hi) { unsigned r; asm volatile("v_cvt_pk_bf16_f32 %0, %1, %2" : "=v"(r) : "v"(lo), "v"(hi)); return r; }

struct EpiProj {
    static constexpr bool PERM = true, AFTER_DRAIN = false;
    bf16_t* P5; bf16_t* YG; const float* rs;
    __device__ __forceinline__ void operator()(const f32x4 (&acc)[2][2][4][2], const Unit& u, int wr, int wc, int fr, int fq) const {
        const int row0 = u.pm * BM + wr * 64 + fr; const int pn = u.pn;
        bf16_t* base; int ldc, colt;
        if (pn < 20) { base = P5; ldc = 5120; colt = pn * BM; } else { base = YG; ldc = 2048; colt = (pn - 20) * BM; }
        const float qs = pn < 4 ? 0.12751743f   : ((pn == 12 || pn == 13) ? 0.08838834764831845f : 1.0f);
        const int col0 = colt + wc * 32 + 8 * fq;
#pragma unroll
        for (int ai = 0; ai < 2; ++ai)
#pragma unroll
            for (int m = 0; m < 4; ++m) { const int row = row0 + ai * HALF + m * 16; const float sc = rs[row] * qs; bf16_t* rowp = base + (size_t)row * ldc + col0;
#pragma unroll
                for (int bj = 0; bj < 2; ++bj) { const f32x4 v0 = acc[ai][bj][m][0] * sc, v1 = acc[ai][bj][m][1] * sc;
                    u32x4 w; w.x = cvt_pk_bf16(v0[0], v0[1]); w.y = cvt_pk_bf16(v0[2], v0[3]); w.z = cvt_pk_bf16(v1[0], v1[1]); w.w = cvt_pk_bf16(v1[2], v1[3]);
                    *(u32x4*)(rowp + bj * HALF) = w; } }
    }
};

struct EpiF32 {
    static constexpr bool PERM = false, AFTER_DRAIN = false;
    float* C; int ldc;
    __device__ __forceinline__ void operator()(const f32x4 (&acc)[2][2][4][2], const Unit& u, int wr, int wc, int fr, int fq) const {
        const int row0 = u.pm * BM + wr * 64 + fr, col0 = u.pn * BM + wc * 32 + 4 * fq;
#pragma unroll
        for (int ai = 0; ai < 2; ++ai)
#pragma unroll
            for (int m = 0; m < 4; ++m) { float* rowp = C + (size_t)(row0 + ai * HALF + m * 16) * ldc + col0;
#pragma unroll
                for (int bj = 0; bj < 2; ++bj)
#pragma unroll
                    for (int n = 0; n < 2; ++n) *(f32x4*)(rowp + bj * HALF + n * 16) = acc[ai][bj][m][n]; }
    }
};

template <class Epi, class Sched, bool ALIGN_EPI = false, bool SP2 = false>
__device__ __forceinline__ void gemm_phase(PG8_LAS unsigned char* lds, const Gemm g, const Sched& S, const Epi& E) {
    const int tid = threadIdx.x, wid = __builtin_amdgcn_readfirstlane(tid >> 6), lane = tid & 63, wr = wid >> 2, wc = wid & 3, fr = lane & 15, fq = lane >> 4;
    const int K = g.K, nt = K / BK;
    unsigned voffA[2], voffB[2];
#pragma unroll
    for (int i = 0; i < 2; ++i) { int R, C; stage_rc(tid * 16 + i * 8192, R, C); const int Rb = Epi::PERM ? ((R & ~31) + perm32(R & 31)) : R;
        voffA[i] = (unsigned)(R * K + C) * 2u; voffB[i] = (unsigned)(Rb * K + C) * 2u; }
    const size_t kstep = (size_t)(BK * 2);
    const size_t hstep = (size_t)HALF * K * 2;
    const size_t tstep = 2 * hstep;
    const unsigned ldsw = (unsigned)wid * 1024u;
    const int aoff = lds_byte(wr * 64 + fr, fq * 8), boff = lds_byte(wc * 32 + fr, fq * 8);
#define PG8_SA(b, h) (((b) * 2 + (h)) * HTB)
#define PG8_SB(b, h) ((4 + (b) * 2 + (h)) * HTB)
#define PG8_STAGE(bufoff, gbase, voff) do { _Pragma("unroll") for (int _i = 0; _i < 2; ++_i) \
        __builtin_amdgcn_global_load_lds((const unsigned*)((const char*)(gbase) + (voff)[_i]), (PG8_LAS unsigned*)(lds + (bufoff) + ldsw + _i * 8192), 16, 0, 0); } while (0)
#define PG8_LDA(dst, b, h) do { _Pragma("unroll") for (int m = 0; m < 4; ++m) _Pragma("unroll") for (int k = 0; k < 2; ++k) dst[m][k] = *(const PG8_LAS bf16x8*)(lds + PG8_SA(b, h) + aoff + m * 2048 + k * 1024); } while (0)
#define PG8_LDB(dst, b, h) do { _Pragma("unroll") for (int n = 0; n < 2; ++n) _Pragma("unroll") for (int k = 0; k < 2; ++k) dst[n][k] = *(const PG8_LAS bf16x8*)(lds + PG8_SB(b, h) + boff + n * 2048 + k * 1024); } while (0)
#define PG8_MMA(ai, bj, At, Bt) do { __builtin_amdgcn_s_setprio(1); _Pragma("unroll") for (int m = 0; m < 4; ++m) _Pragma("unroll") for (int n = 0; n < 2; ++n) _Pragma("unroll") for (int k = 0; k < 2; ++k) \
        acc[ai][bj][m][n] = __builtin_amdgcn_mfma_f32_16x16x32_bf16(Bt[n][k], At[m][k], acc[ai][bj][m][n], 0, 0, 0); __builtin_amdgcn_s_setprio(0); } while (0)
#define PG8_WAIT_V(n) asm volatile("s_waitcnt vmcnt(" #n ")" ::: "memory")
#define PG8_WAIT_L(n) asm volatile("s_waitcnt lgkmcnt(" #n ")" ::: "memory")
#define PG8_BAR __builtin_amdgcn_s_barrier()
#define PG8_SCHED __builtin_amdgcn_sched_barrier(0)
    Unit cur, nxt; int ui = 0;
    if (!S.next(0, cur)) return;
    f32x4 acc[2][2][4][2];
#pragma unroll
    for (int a = 0; a < 2; ++a)
#pragma unroll
        for (int b = 0; b < 2; ++b)
#pragma unroll
            for (int m = 0; m < 4; ++m)
#pragma unroll
                for (int n = 0; n < 2; ++n) acc[a][b][m][n] = (f32x4){0.f, 0.f, 0.f, 0.f};
    bf16x8 At[4][2], B0[2][2], B1[2][2];
    const char* cA = (const char*)g.A + (size_t)cur.pm * tstep; const char* cB = (const char*)g.Bt + (size_t)cur.pn * tstep;
    S.a_ready(cur);
    if constexpr (SP2) {
        PG8_STAGE(PG8_SB(0, 0), cB, voffB); PG8_STAGE(PG8_SB(0, 1), cB + hstep, voffB); PG8_STAGE(PG8_SA(0, 0), cA, voffA); PG8_STAGE(PG8_SA(0, 1), cA + hstep, voffA);
        if (wr == 1) PG8_BAR;
        PG8_WAIT_V(2); PG8_BAR;
        PG8_STAGE(PG8_SB(1, 0), cB + kstep, voffB); PG8_STAGE(PG8_SA(1, 0), cA + kstep, voffA); PG8_STAGE(PG8_SB(1, 1), cB + hstep + kstep, voffB);
        PG8_WAIT_V(6); PG8_BAR;
    } else {
        PG8_STAGE(PG8_SB(0, 0), cB, voffB); PG8_STAGE(PG8_SA(0, 0), cA, voffA); PG8_STAGE(PG8_SB(0, 1), cB + hstep, voffB); PG8_STAGE(PG8_SA(0, 1), cA + hstep, voffA);
        if (wr == 1) PG8_BAR;
        PG8_WAIT_V(4); PG8_BAR;
        PG8_STAGE(PG8_SB(1, 0), cB + kstep, voffB); PG8_STAGE(PG8_SA(1, 0), cA + kstep, voffA); PG8_STAGE(PG8_SB(1, 1), cB + hstep + kstep, voffB);
        PG8_WAIT_V(6); PG8_BAR;
    }
    for (;;) {
        const bool has_next = S.next(ui + 1, nxt);
        const char* nA = has_next ? (const char*)g.A + (size_t)nxt.pm * tstep : cA; const char* nB = has_next ? (const char*)g.Bt + (size_t)nxt.pn * tstep : cB;
        for (int t = 0; t < nt; t += 2) {
            const bool last = (t == nt - 2);
            const char* a1 = cA + (size_t)(t + 1) * kstep;
            const char* a2 = last ? nA : cA + (size_t)(t + 2) * kstep; const char* b2 = last ? nB : cB + (size_t)(t + 2) * kstep;
            const char* a3 = a2 + kstep; const char* b3 = b2 + kstep;
            if (last && has_next) S.a_ready(nxt);
            if constexpr (SP2) {
            PG8_LDB(B0, 0, 0); PG8_LDB(B1, 0, 1); PG8_SCHED; PG8_LDA(At, 0, 0); PG8_STAGE(PG8_SA(1, 1), a1 + hstep, voffA);
            PG8_WAIT_V(8); PG8_WAIT_L(0); PG8_BAR; PG8_MMA(0, 0, At, B0); PG8_MMA(0, 1, At, B1); PG8_BAR; PG8_SCHED;
            PG8_LDA(At, 0, 1); PG8_STAGE(PG8_SB(0, 0), b2, voffB); PG8_STAGE(PG8_SB(0, 1), b2 + hstep, voffB); PG8_STAGE(PG8_SA(0, 0), a2, voffA);
            PG8_WAIT_V(8); PG8_WAIT_L(0); PG8_BAR; PG8_MMA(1, 0, At, B0); PG8_MMA(1, 1, At, B1); PG8_BAR; PG8_SCHED;
            PG8_LDB(B0, 1, 0); PG8_LDB(B1, 1, 1); PG8_SCHED; PG8_LDA(At, 1, 0); PG8_STAGE(PG8_SA(0, 1), a2 + hstep, voffA);
            PG8_WAIT_V(8); PG8_WAIT_L(0); PG8_BAR; PG8_MMA(0, 0, At, B0); PG8_MMA(0, 1, At, B1); PG8_BAR; PG8_SCHED;
            PG8_LDA(At, 1, 1); PG8_STAGE(PG8_SB(1, 0), b3, voffB); PG8_STAGE(PG8_SB(1, 1), b3 + hstep, voffB); PG8_STAGE(PG8_SA(1, 0), a3, voffA);
            PG8_WAIT_V(8); PG8_WAIT_L(0); PG8_BAR; PG8_MMA(1, 0, At, B0); PG8_MMA(1, 1, At, B1); PG8_BAR; PG8_SCHED;
            } else {
            PG8_LDB(B0, 0, 0); PG8_SCHED; PG8_LDA(At, 0, 0); PG8_STAGE(PG8_SA(1, 1), a1 + hstep, voffA);
            PG8_WAIT_L(8); PG8_BAR; PG8_WAIT_L(0); PG8_MMA(0, 0, At, B0); PG8_BAR; PG8_SCHED;
            PG8_LDB(B1, 0, 1); PG8_STAGE(PG8_SB(0, 0), b2, voffB);
            PG8_BAR; PG8_WAIT_L(0); PG8_MMA(0, 1, At, B1); PG8_BAR;
            PG8_LDA(At, 0, 1); PG8_STAGE(PG8_SA(0, 0), a2, voffA);
            PG8_BAR; PG8_WAIT_L(0); PG8_MMA(1, 0, At, B0); PG8_BAR; PG8_SCHED;
            PG8_STAGE(PG8_SB(0, 1), b2 + hstep, voffB);
            PG8_WAIT_V(6); PG8_BAR; PG8_MMA(1, 1, At, B1); PG8_BAR;
            PG8_LDB(B0, 1, 0); PG8_SCHED; PG8_LDA(At, 1, 0); PG8_STAGE(PG8_SA(0, 1), a2 + hstep, voffA);
            PG8_WAIT_L(8); PG8_BAR; PG8_WAIT_L(0); PG8_MMA(0, 0, At, B0); PG8_BAR; PG8_SCHED;
            PG8_LDB(B1, 1, 1); PG8_STAGE(PG8_SB(1, 0), b3, voffB);
            PG8_BAR; PG8_WAIT_L(0); PG8_MMA(0, 1, At, B1); PG8_BAR;
            PG8_LDA(At, 1, 1); PG8_STAGE(PG8_SA(1, 0), a3, voffA);
            PG8_BAR; PG8_WAIT_L(0); PG8_MMA(1, 0, At, B0); PG8_BAR; PG8_SCHED;
            PG8_STAGE(PG8_SB(1, 1), b3 + hstep, voffB);
            PG8_WAIT_V(6); PG8_BAR; PG8_MMA(1, 1, At, B1); PG8_BAR;
            }
        }
        if constexpr (ALIGN_EPI) { if (wr == 0) PG8_BAR; }
        if constexpr (!Epi::AFTER_DRAIN) { E(acc, cur, wr, wc, fr, fq); S.done(cur); }
        if (!has_next) break;
#pragma unroll
        for (int a = 0; a < 2; ++a)
#pragma unroll
            for (int b = 0; b < 2; ++b)
#pragma unroll
                for (int m = 0; m < 4; ++m)
#pragma unroll
                    for (int n = 0; n < 2; ++n) acc[a][b][m][n] = (f32x4){0.f, 0.f, 0.f, 0.f};
        cur = nxt; cA = nA; cB = nB; ++ui;
        if constexpr (ALIGN_EPI) { if (wr == 1) PG8_BAR; }
    }
    PG8_WAIT_V(0);
    if constexpr (!ALIGN_EPI) { if (wr == 0) PG8_BAR; }
    PG8_BAR;
    if constexpr (Epi::AFTER_DRAIN) { E.fused(acc, cur, wr, wc, fr, fq, lds, wid, lane); S.done(cur); }
#undef PG8_SA
#undef PG8_SB
#undef PG8_STAGE
#undef PG8_LDA
#undef PG8_LDB
#undef PG8_MMA
#undef PG8_WAIT_V
#undef PG8_WAIT_L
#undef PG8_BAR
#undef PG8_SCHED
}
}
#define GAS __attribute__((address_space(1)))
#define LAS __attribute__((address_space(3)))
typedef unsigned short bf16;
typedef unsigned v4u __attribute__((ext_vector_type(4)));
typedef float f32x4 __attribute__((ext_vector_type(4)));
typedef short bf16x8 __attribute__((ext_vector_type(8)));
typedef GAS unsigned gu32;
typedef GAS unsigned long long gu64;
#define RLX_AGENT __ATOMIC_RELAXED, __HIP_MEMORY_SCOPE_AGENT
#define LDS_WAIT() asm volatile("s_waitcnt lgkmcnt(0)" ::: "memory")
#define VM_WAIT() asm volatile("s_waitcnt vmcnt(0)" ::: "memory")
__device__ __forceinline__ unsigned long long rt() { return __builtin_amdgcn_s_memrealtime(); }
__device__ __forceinline__ unsigned f2bf(float f) { unsigned u = __builtin_bit_cast(unsigned, f); return (u + 0x7fffu + ((u >> 16) & 1u)) >> 16; }
__device__ __forceinline__ unsigned pk2(float lo, float hi) { return f2bf(lo) | (f2bf(hi) << 16); }

#define XB_TMO      128
#define XB_XCNT(j)  (256  + 64 * (j))
#define XB_XSUB(j)  (1280 + 64 * (j))
#define XB_XGEN(j)  (2304 + 64 * (j))
#define XB_TOP      3328
#define XB_TOPGEN   3392
#define XCD_BAR_WORDS 3456
#define XB_SPIN_CAP (1u << 24)

__device__ __forceinline__ unsigned xb_ld(unsigned* p)              { return __hip_atomic_load(p, __ATOMIC_RELAXED, __HIP_MEMORY_SCOPE_AGENT); }
__device__ __forceinline__ unsigned xb_add(unsigned* p, unsigned v) { return __hip_atomic_fetch_add(p, v, __ATOMIC_RELAXED, __HIP_MEMORY_SCOPE_AGENT); }
__device__ __forceinline__ unsigned xb_xcc_id() { return (unsigned)__builtin_amdgcn_s_getreg((3 << 11) | 20) & 0xFu; }
#define XB_SPIN(cond, bar) do { unsigned _sp = 0; while (cond) { __builtin_amdgcn_s_sleep(1); \
    if ((++_sp & 255u) == 0u) { if (xb_ld(&(bar)[XB_TMO])) break; if (_sp > XB_SPIN_CAP) { atomicAdd(&(bar)[XB_TMO], 1u); break; } } } } while (0)

struct XcdBarrier {
    unsigned* bar; unsigned x;
    volatile LAS unsigned* st;
};

__device__ __forceinline__ XcdBarrier xcd_barrier_post(unsigned* bar, volatile LAS unsigned* st) {
    XcdBarrier b; b.bar = bar; b.x = xb_xcc_id(); b.st = st;
    if (threadIdx.x == 0) (void)xb_add(&bar[XB_XCNT(b.x)], 1u);
    return b;
}
__device__ __forceinline__ void xcd_barrier_complete(unsigned* bar, unsigned x, unsigned& nloc, unsigned& nx) {
    const unsigned G = gridDim.x * gridDim.y * gridDim.z;
    unsigned sum, cnt, mine, sp = 0u;
    for (;;) {
        sum = 0u; cnt = 0u; mine = 0u;
#pragma unroll
        for (unsigned j = 0; j < 16; ++j) { const unsigned c = xb_ld(&bar[XB_XCNT(j)]); sum += c; cnt += (c > 0u) ? 1u : 0u; mine = (j == x) ? c : mine; }
        if (sum == G) break;
        __builtin_amdgcn_s_sleep(1);
        if ((++sp & 255u) == 0u) { if (xb_ld(&bar[XB_TMO])) break; if (sp > XB_SPIN_CAP) { atomicAdd(&bar[XB_TMO], 1u); break; } }
    }
    nloc = mine > 0u ? mine : 1u; nx = cnt > 0u ? cnt : 1u;
}

__device__ __forceinline__ void xcd_barrier(const XcdBarrier& b) {
    asm volatile("s_waitcnt vmcnt(0)" ::: "memory");
    __syncthreads();
    if (threadIdx.x == 0) {
        unsigned* bar = b.bar;
        __builtin_amdgcn_s_waitcnt(0);
        unsigned nloc = b.st[0], nx = b.st[1];
        if (nloc == 0u) { xcd_barrier_complete(bar, b.x, nloc, nx); b.st[0] = nloc; b.st[1] = nx; }
        const unsigned old = xb_add(&bar[XB_XSUB(b.x)], 1u);
        const unsigned gen = old / nloc;
        if (old + 1u == (gen + 1u) * nloc) {
            __builtin_amdgcn_fence(__ATOMIC_RELEASE, "agent");
            asm volatile("s_waitcnt vmcnt(0)" ::: "memory");
            const unsigned og = xb_add(&bar[XB_TOP], 1u);
            const unsigned tg = og / nx;
            if (og + 1u == (tg + 1u) * nx) xb_add(&bar[XB_TOPGEN], 1u);
            else XB_SPIN(xb_ld(&bar[XB_TOPGEN]) == tg, bar);
            __builtin_amdgcn_fence(__ATOMIC_ACQUIRE, "agent");
            xb_add(&bar[XB_XGEN(b.x)], 1u);
            asm volatile("s_waitcnt vmcnt(0)" ::: "memory");
        } else {
            XB_SPIN(xb_ld(&bar[XB_XGEN(b.x)]) == gen, bar);
            __builtin_amdgcn_fence(__ATOMIC_ACQUIRE, "agent");
            asm volatile("s_waitcnt vmcnt(0)" ::: "memory");
        }
    }
    __syncthreads();
}

constexpr int NWAVES = 8;
constexpr int BATCH = 4, SEQ = 8192, D = 1024, M = BATCH * SEQ;
constexpr int NIN = 7184, NPROJ = 7168;
constexpr int P5W = 5120, YGW = 2048;
constexpr int P5_SBQ = 0, P5_SBK = 1024, P5_SBV = 2048, P5_GQ = 3072, P5_GK = 3584, P5_GV = 4096;
constexpr int SBH = 8, SBD = 128, GH = 4, GDK = 128, GDV = 256, RANK = 16;
constexpr float NORM_EPS = 1e-6f;

constexpr size_t MiB = 1u << 20;
constexpr size_t WS_CTL = 0, CTL_ZERO_BYTES = 1 * MiB;
constexpr size_t WS_WIN = 2 * MiB;
constexpr size_t WS_WOUT = 16 * MiB;
constexpr size_t WS_RS = 20 * MiB;
constexpr size_t WS_LR = 21 * MiB;
constexpr size_t WS_P5 = 24 * MiB;
constexpr size_t WS_YG = 344 * MiB;
constexpr size_t WS_END = 472 * MiB;
constexpr int CW_BAR = 4096;

constexpr int RING_OFF = 0, RING_BYTES = 131072;
constexpr int LDSCTL_OFF = RING_BYTES, MISC_OFF = LDSCTL_OFF + 320;
constexpr int LDS_BYTES = 147456;

struct Frame {
    LAS unsigned char* lds;
    volatile LAS unsigned* MISC;
    gu32* ctl;
    int tid, lane, wave;
    int vcu, G;
};

__device__ __forceinline__ float wave_sum(float v) {
#pragma unroll
    for (int o = 1; o < 64; o <<= 1) v += __shfl_xor(v, o);
    return v;
}
__device__ __forceinline__ float bf2f(unsigned short b) { return __uint_as_float(((unsigned)b) << 16); }

__device__ __forceinline__ void p0_transpose_item(const float* W, int ldw, int n_src0, const float* kscale, bf16* WT, int K, int n_dst0, int k0, LAS float* scr, int lane) {
#pragma unroll 8
    for (int i = 0; i < 32; ++i) { const int kk = 2 * i + (lane >> 5); float v = W[(size_t)(k0 + kk) * ldw + n_src0 + (lane & 31)]; if (kscale) v *= kscale[k0 + kk]; scr[kk * 33 + (lane & 31)] = v; }
    LDS_WAIT(); asm volatile("" ::: "memory");
    const int c = lane & 7;
#pragma unroll
    for (int j = 0; j < 4; ++j) { const int n = (lane >> 3) + 8 * j; const LAS float* s = scr + (8 * c) * 33 + n;
        v4u o; o.x = pk2(s[0 * 33], s[1 * 33]); o.y = pk2(s[2 * 33], s[3 * 33]); o.z = pk2(s[4 * 33], s[5 * 33]); o.w = pk2(s[6 * 33], s[7 * 33]);
        *(GAS v4u*)(WT + (size_t)(n_dst0 + n) * K + k0 + 8 * c) = o; }
    LDS_WAIT(); asm volatile("" ::: "memory");
}
__device__ __forceinline__ int win_src_col(int n) { return n < 3072 ? n : (n < 5120 ? n + 1024 : (n < 6144 ? n - 2048 : n)); }

struct Args { const float* in[9]; float* out; unsigned char* ws; int ph_lo, ph_hi, li, pad; };

__device__ __forceinline__ void p0_prologue(Frame& F, const Args& a) {
    const float* x = a.in[0]; const float* pre_w = a.in[1]; const float* w_in = a.in[2]; const float* w_out = a.in[7];
    bf16* WinT = (bf16*)(a.ws + WS_WIN); bf16* WoutT = (bf16*)(a.ws + WS_WOUT);
    float* RS = (float*)(a.ws + WS_RS); float* LR = (float*)(a.ws + WS_LR);
    bf16* XB = (bf16*)a.out;
    const int gw = F.vcu * NWAVES + F.wave, NGW = F.G * NWAVES;
    {
        LAS float* scr = (LAS float*)(F.lds + RING_OFF + F.wave * 16384);
        constexpr int I_IN = (D / 64) * (NPROJ / 32), I_OUT = (2048 / 64) * (D / 32);
        for (int it = gw; it < I_IN + I_OUT; it += NGW) {
            if (it < I_IN) { const int nb = it % (NPROJ / 32), kb = it / (NPROJ / 32); p0_transpose_item(w_in, NIN, win_src_col(32 * nb), pre_w, WinT, D, 32 * nb, 64 * kb, scr, F.lane); }
            else { const int r = it - I_IN, nb = r % (D / 32), kb = r / (D / 32); p0_transpose_item(w_out, D, 32 * nb, nullptr, WoutT, 2048, 32 * nb, 64 * kb, scr, F.lane); }
        }
    }
    __syncthreads();
    LAS float* WL = (LAS float*)(F.lds + RING_OFF);
    for (int k = F.tid; k < D; k += NWAVES * 64) {
        const float g = pre_w[k]; const f32x4* src = (const f32x4*)(w_in + (size_t)k * NIN + NPROJ);
#pragma unroll
        for (int q = 0; q < 4; ++q) { const f32x4 w = src[q]; WL[(4 * q + 0) * D + k] = w.x * g; WL[(4 * q + 1) * D + k] = w.y * g; WL[(4 * q + 2) * D + k] = w.z * g; WL[(4 * q + 3) * D + k] = w.w * g; }
    }
    __syncthreads();
    for (int m = gw; m < M; m += NGW) {
        const GAS f32x4* xr = (const GAS f32x4*)(x + (size_t)m * D) + F.lane;
        f32x4 v[4]; float s = 0.f;
#pragma unroll
        for (int j = 0; j < 4; ++j) { v[j] = xr[64 * j]; s += (v[j].x * v[j].x + v[j].y * v[j].y) + (v[j].z * v[j].z + v[j].w * v[j].w); }
        const float rstd = 1.0f / sqrtf(wave_sum(s) * (1.f / D) + NORM_EPS);
        GAS unsigned long long* o8 = (GAS unsigned long long*)(XB + (size_t)m * D) + F.lane;
#pragma unroll
        for (int j = 0; j < 4; ++j) o8[64 * j] = (unsigned long long)pk2(v[j].x, v[j].y) | ((unsigned long long)pk2(v[j].z, v[j].w) << 32);
        float p[16];
#pragma unroll
        for (int n = 0; n < 16; ++n) { float acc = 0.f;
#pragma unroll
            for (int j = 0; j < 4; ++j) { const f32x4 w = *(const LAS f32x4*)(WL + n * D + 4 * F.lane + 256 * j); acc += (v[j].x * w.x + v[j].y * w.y) + (v[j].z * w.z + v[j].w * w.w); }
            p[n] = acc; if (n & 1) asm volatile("" ::: "memory"); }
        float q8[8], q4[4], q2[2], q1;
        { const bool hi = (F.lane & 32) != 0;
#pragma unroll
          for (int i = 0; i < 8; ++i) { const float keep = hi ? p[i + 8] : p[i], send = hi ? p[i] : p[i + 8]; q8[i] = keep + __shfl_xor(send, 32); } }
        { const bool hi = (F.lane & 16) != 0;
#pragma unroll
          for (int i = 0; i < 4; ++i) { const float keep = hi ? q8[i + 4] : q8[i], send = hi ? q8[i] : q8[i + 4]; q4[i] = keep + __shfl_xor(send, 16); } }
        { const bool hi = (F.lane & 8) != 0;
#pragma unroll
          for (int i = 0; i < 2; ++i) { const float keep = hi ? q4[i + 2] : q4[i], send = hi ? q4[i] : q4[i + 2]; q2[i] = keep + __shfl_xor(send, 8); } }
        { const bool hi = (F.lane & 4) != 0; const float keep = hi ? q2[1] : q2[0], send = hi ? q2[0] : q2[1]; q1 = keep + __shfl_xor(send, 4); }
        q1 += __shfl_xor(q1, 2); q1 += __shfl_xor(q1, 1);
        if ((F.lane & 3) == 0) { const int n = ((F.lane >> 5) & 1) * 8 + ((F.lane >> 4) & 1) * 4 + ((F.lane >> 3) & 1) * 2 + ((F.lane >> 2) & 1); LR[(size_t)m * RANK + n] = q1 * rstd; }
        if (F.lane == 0) RS[m] = rstd;
    }
}

__device__ __forceinline__ void p4_final(Frame& F, const Args& a) {
    const float* x = a.in[0]; const float* post_w = a.in[8]; float* out = a.out;
    const int gw = F.vcu * NWAVES + F.wave, NGW = F.G * NWAVES;
    f32x4 g[4];
#pragma unroll
    for (int j = 0; j < 4; ++j) g[j] = *((const f32x4*)post_w + F.lane + 64 * j);
    for (int m = gw; m < M; m += NGW) {
        GAS f32x4* yr = (GAS f32x4*)(out + (size_t)m * D) + F.lane; const GAS f32x4* xr = (const GAS f32x4*)(x + (size_t)m * D) + F.lane;
        f32x4 v[4], xv[4]; float s = 0.f;
#pragma unroll
        for (int j = 0; j < 4; ++j) { v[j] = yr[64 * j]; xv[j] = xr[64 * j]; s += (v[j].x * v[j].x + v[j].y * v[j].y) + (v[j].z * v[j].z + v[j].w * v[j].w); }
        const float rstd = 1.0f / sqrtf(wave_sum(s) * (1.f / D) + NORM_EPS);
#pragma unroll
        for (int j = 0; j < 4; ++j) yr[64 * j] = xv[j] + (v[j] * rstd) * g[j];
    }
}

typedef float f32x16 __attribute__((ext_vector_type(16)));
typedef short s16x4 __attribute__((ext_vector_type(4)));
typedef float f32x2_t __attribute__((ext_vector_type(2)));
typedef __bf16 bf16x2_t __attribute__((ext_vector_type(2)));
#define MFMA32(a, b, c) __builtin_amdgcn_mfma_f32_32x32x16_bf16((a), (b), (c), 0, 0, 0)
__device__ __forceinline__ unsigned cvtpk(float lo, float hi) { f32x2_t v = {lo, hi}; bf16x2_t b = __builtin_convertvector(v, bf16x2_t); return __builtin_bit_cast(unsigned, b); }
__device__ __forceinline__ unsigned off_a(unsigned row, unsigned ch) { return 2048u * (row >> 3) + 512u * (ch >> 2) + 64u * (row & 7) + 16u * ((ch & 3) ^ ((row >> 2) & 3)); }
__device__ __forceinline__ s16x4 tr_read(LAS unsigned char* p) { return __builtin_amdgcn_ds_read_tr16_b64_v4i16((LAS s16x4*)p); }
__device__ __forceinline__ bf16x8 cat8(s16x4 lo, s16x4 hi) { return __builtin_shufflevector(lo, hi, 0, 1, 2, 3, 4, 5, 6, 7); }
constexpr float LOG2E = 1.4426950408889634f;

__device__ __forceinline__ void sb_phase(Frame& F, const bf16* __restrict__ P5, bf16* YG, const float* __restrict__ sb_norm_w) {
    LAS unsigned char* vimg = F.lds + RING_OFF + F.wave * 8192;
    const int lane = F.lane, r = lane & 31, h = lane >> 5;
    const int kap = 16 * ((r >> 2) & 1) + 4 * (r >> 3) + (r & 3);
    const unsigned blk = (lane >> 4) & 1, q4 = (lane & 15) >> 2, p4 = lane & 3;
    const int nitem = BATCH * SBH * (SEQ / 32), nw = F.G * NWAVES;
    for (int item = F.vcu * NWAVES + F.wave; item < nitem; item += nw) {
        const int qb = item & 255, hd = (item >> 8) & 7, b = item >> 11;
        const size_t rowq = (size_t)b * SEQ + 32 * qb + r;
        bf16x8 qf[8];
        { const bf16* qp = P5 + rowq * P5W + P5_SBQ + hd * SBD + 8 * h;
#pragma unroll
          for (int s = 0; s < 8; ++s) qf[s] = *(const bf16x8*)(qp + 16 * s); }
        f32x16 O[4];
#pragma unroll
        for (int c = 0; c < 4; ++c)
#pragma unroll
            for (int i = 0; i < 16; ++i) O[c][i] = 0.f;
        float carry = 0.f;
        for (int kt = qb; kt >= 0; --kt) {
            const size_t rowk0 = (size_t)b * SEQ + 32 * kt;
            bf16x8 kf[8];
            { const bf16* kp = P5 + (rowk0 + kap) * P5W + P5_SBK + hd * SBD + 8 * h;
#pragma unroll
              for (int s = 0; s < 8; ++s) kf[s] = *(const bf16x8*)(kp + 16 * s); }
#pragma unroll
            for (int i = 0; i < 8; ++i) { const int n = lane + 64 * i, row = n >> 4, ch = n & 15;
                const v4u v = *(const v4u*)(P5 + (rowk0 + row) * P5W + P5_SBV + hd * SBD + 8 * ch);
                *(LAS v4u*)(vimg + off_a(row, ch)) = v; }
            f32x16 C;
#pragma unroll
            for (int i = 0; i < 16; ++i) C[i] = 0.f;
#pragma unroll
            for (int s = 0; s < 8; ++s) C = MFMA32(kf[s], qf[s], C);
            const int lim = (kt == qb) ? r : 64;
            float aft[16]; float run = 0.f;
#pragma unroll
            for (int i = 15; i >= 0; --i) {
                const float z = C[i];
                const float sp = fmaxf(z, 0.f) + __builtin_amdgcn_logf(1.0f + __builtin_amdgcn_exp2f(-fabsf(z)));
                const bool valid = (16 * h + i) < lim;
                const float lf = valid ? -sp : 0.f;
                C[i] = valid ? (z - sp) : -1000.f;
                aft[i] = run; run += lf;
            }
            const float other = __shfl_xor(run, 32);
            const float base = carry + (h == 0 ? other : 0.f);
            carry += run + other;
            unsigned pw[8];
#pragma unroll
            for (int i = 0; i < 8; ++i) pw[i] = cvtpk(__builtin_amdgcn_exp2f(C[2 * i] + aft[2 * i] + base), __builtin_amdgcn_exp2f(C[2 * i + 1] + aft[2 * i + 1] + base));
            bf16x8 ps[2];
            { const v4u a = {pw[0], pw[1], pw[2], pw[3]}, bb = {pw[4], pw[5], pw[6], pw[7]}; ps[0] = __builtin_bit_cast(bf16x8, a); ps[1] = __builtin_bit_cast(bf16x8, bb); }
#pragma unroll
            for (int c = 0; c < 4; ++c)
#pragma unroll
                for (int ks = 0; ks < 2; ++ks) {
                    const unsigned ch = 4 * c + 2 * blk + (p4 >> 1), bo = 8 * (p4 & 1);
                    const s16x4 lo = tr_read(vimg + off_a(16 * h + 8 * ks + q4, ch) + bo);
                    const s16x4 hi = tr_read(vimg + off_a(16 * h + 8 * ks + 4 + q4, ch) + bo);
                    O[c] = MFMA32(cat8(lo, hi), ps[ks], O[c]);
                }
            if (__all(carry < -160.f)) break;
        }
        float ss = 0.f;
#pragma unroll
        for (int c = 0; c < 4; ++c)
#pragma unroll
            for (int i = 0; i < 16; ++i) ss += O[c][i] * O[c][i];
        ss += __shfl_xor(ss, 32);
        const float rstd = __builtin_amdgcn_rsqf(ss * (1.f / SBD) + NORM_EPS);
        bf16* yrow = YG + rowq * YGW + hd * SBD + 4 * h;
        const float* nwp = sb_norm_w + hd * SBD + 4 * h;
#pragma unroll
        for (int c = 0; c < 4; ++c)
#pragma unroll
            for (int g = 0; g < 4; ++g) {
                const int d0 = 32 * c + 8 * g;
                const uint2 gg = *(const uint2*)(yrow + d0); const f32x4 nw = *(const f32x4*)(nwp + d0);
                const float g0 = bf2f(gg.x & 0xffff), g1 = bf2f(gg.x >> 16), g2 = bf2f(gg.y & 0xffff), g3 = bf2f(gg.y >> 16);
                const float y0 = O[c][4 * g + 0] * rstd * nw.x * (g0 * __builtin_amdgcn_rcpf(1.0f + __builtin_amdgcn_exp2f(-g0 * LOG2E)));
                const float y1 = O[c][4 * g + 1] * rstd * nw.y * (g1 * __builtin_amdgcn_rcpf(1.0f + __builtin_amdgcn_exp2f(-g1 * LOG2E)));
                const float y2 = O[c][4 * g + 2] * rstd * nw.z * (g2 * __builtin_amdgcn_rcpf(1.0f + __builtin_amdgcn_exp2f(-g2 * LOG2E)));
                const float y3 = O[c][4 * g + 3] * rstd * nw.w * (g3 * __builtin_amdgcn_rcpf(1.0f + __builtin_amdgcn_exp2f(-g3 * LOG2E)));
                uint2 o; o.x = cvtpk(y0, y1); o.y = cvtpk(y2, y3);
                *(uint2*)(yrow + d0) = o;
            }
    }
}

constexpr int GL_QI = 0, GL_KI = 16384, GL_KH = 32768, GL_PI = 49152, GL_PSTRIDE = 144, GL_OS = 0, GL_OSP = 260;
constexpr int GL_VI = 58368, GL_BM = 91136, GL_LRS = 123904, GL_QT = 128000, GL_DV = 130048;
static_assert(GL_DV + 512 <= RING_BYTES, "GLA LDS map");
constexpr size_t GLA_LST_OFF = 0, GLA_DT_OFF = 64 * MiB;

typedef unsigned u32x2v __attribute__((ext_vector_type(2)));
__device__ __forceinline__ unsigned short f2bf16(float f) { return (unsigned short)f2bf(f); }
__device__ __forceinline__ unsigned img64(int row, int col) { return (unsigned)(row >> 5) * 8192u + off_a((unsigned)(row & 31), (unsigned)(col >> 3)) + (unsigned)(col & 7) * 2u; }

constexpr size_t WS_QK0 = 23 * MiB;
__device__ __forceinline__ void gla_t0_exact(Frame& F, const Args& a) {
    const float* x = a.in[0]; const float* pre_w = a.in[1]; const float* w_in = a.in[2]; const float* RS = (const float*)(a.ws + WS_RS);
    float* QK0 = (float*)(a.ws + WS_QK0);
    LAS float* red = (LAS float*)(F.lds + RING_OFF + 65536);
    for (int task = (int)blockIdx.x; task < 64; task += F.G) {
        const int b = task >> 4, cg = task & 15;
        const float* xr = x + (size_t)b * SEQ * D; const float* wc = w_in + 4096 + cg * 64 + F.lane;
        float acc = 0.f;
#pragma unroll 8
        for (int k = 128 * F.wave; k < 128 * F.wave + 128; ++k) acc += (xr[k] * pre_w[k]) * wc[(size_t)k * NIN];
        red[F.wave * 64 + F.lane] = acc;
        __syncthreads();
        if (F.wave == 0) { float s = 0.f;
#pragma unroll
            for (int w8 = 0; w8 < 8; ++w8) s += red[w8 * 64 + F.lane];
            QK0[b * 1024 + cg * 64 + F.lane] = s * RS[(size_t)b * SEQ]; }
        __syncthreads();
    }
}

template <bool OUT>
__device__ __forceinline__ void gla_pass(Frame& F, const Args& a) {
    const bf16* P5 = (const bf16*)(a.ws + WS_P5); bf16* YG = (bf16*)(a.ws + WS_YG); const float* LR = (const float*)(a.ws + WS_LR);
    const float* w_alpha2 = a.in[3]; const float* b_alpha2 = a.in[4]; const float* gnw = a.in[6];
    float* LST = (float*)((char*)a.out + GLA_LST_OFF); float* DT = (float*)((char*)a.out + GLA_DT_OFF);
    LAS unsigned char* L = F.lds + RING_OFF;
    LAS float* LRS = (LAS float*)(L + GL_LRS); LAS float* QT = (LAS float*)(L + GL_QT); LAS float* DV = (LAS float*)(L + GL_DV); LAS float* OS = (LAS float*)(L + GL_OS); LAS float* BM = (LAS float*)(L + GL_BM);
    const int w = F.wave, dvh = w >> 2, cw = w & 3;
    for (int item = (int)blockIdx.x; item < 256; item += F.G) {
        const int bh = item >> 4, sc = item & 15, b = bh >> 2, hd = bh & 3;
        if (!OUT && sc == 15) continue;
        f32x16 S[4];
        const int lane0 = F.lane, r0 = lane0 & 31, h0 = lane0 >> 5;
        float* sbase = LST + ((size_t)(bh * 16 + sc) * GDK) * GDV + 32 * w + r0;
        if (OUT && sc > 0) {
#pragma unroll
            for (int k4 = 0; k4 < 4; ++k4)
#pragma unroll
                for (int i = 0; i < 16; ++i) S[k4][i] = sbase[(size_t)(32 * k4 + (i & 3) + 8 * (i >> 2) + 4 * h0) * GDV];
        } else {
#pragma unroll
            for (int k4 = 0; k4 < 4; ++k4)
#pragma unroll
                for (int i = 0; i < 16; ++i) S[k4][i] = 0.f;
        }
        float sumB[8];
#pragma unroll
        for (int e = 0; e < 8; ++e) sumB[e] = 0.f;
        f32x4 nw = {0.f, 0.f, 0.f, 0.f};
        if (OUT) nw = *(const f32x4*)(gnw + hd * GDV + 4 * lane0);
        for (int c = 0; c < 8; ++c) {
            int tid = F.tid; asm volatile("" : "+v"(tid));
            const int lane = tid & 63, r = lane & 31, h = lane >> 5;
            const unsigned blk = (lane >> 4) & 1, q4 = (lane & 15) >> 2, p4 = lane & 3, bo = 8 * (p4 & 1);
            const int dk = tid & 127, tq = __builtin_amdgcn_readfirstlane(tid >> 7);
            const size_t row0 = (size_t)b * SEQ + sc * 512 + c * 64;
            { const f32x2_t v = *(const f32x2_t*)(LR + row0 * RANK + 2 * tid); *(LAS f32x2_t*)(LRS + 2 * tid) = v; }
            float wa[16];
#pragma unroll
            for (int j = 0; j < 16; ++j) wa[j] = w_alpha2[j * 512 + hd * GDK + dk];
            const float ba = b_alpha2[hd * GDK + dk];
            __syncthreads();
            {
                float run = 0.f;
#pragma unroll
                for (int i = 0; i < 16; ++i) {
                    const LAS f32x4* lp = (const LAS f32x4*)(LRS + (16 * tq + i) * RANK);
                    const f32x4 l0 = lp[0], l1 = lp[1], l2 = lp[2], l3 = lp[3];
                    float lg = ba;
                    lg += l0.x * wa[0] + l0.y * wa[1] + l0.z * wa[2] + l0.w * wa[3];
                    lg += l1.x * wa[4] + l1.y * wa[5] + l1.z * wa[6] + l1.w * wa[7];
                    lg += l2.x * wa[8] + l2.y * wa[9] + l2.z * wa[10] + l2.w * wa[11];
                    lg += l3.x * wa[12] + l3.y * wa[13] + l3.z * wa[14] + l3.w * wa[15];
                    const float x2 = lg * LOG2E;
                    const float ls2 = -(fmaxf(-x2, 0.f) + __builtin_amdgcn_logf(1.0f + __builtin_amdgcn_exp2f(-fabsf(x2))));
                    run += ls2 * (1.0f / 16.0f);
                    BM[(16 * tq + i) * 128 + dk] = run;
                    if ((i & 3) == 3) asm volatile("" ::: "memory");
                }
                QT[tq * 128 + dk] = run;
            }
            __syncthreads();
#pragma unroll
            for (int i2 = 0; i2 < 2; ++i2) {
                const int n = tid + 512 * i2, t = n >> 4, c8 = n & 15, tqq = t >> 4;
                float Bi[8], bl[8];
                { const f32x4 b0 = *(const LAS f32x4*)(BM + t * 128 + 8 * c8), b1 = *(const LAS f32x4*)(BM + t * 128 + 8 * c8 + 4);
                  Bi[0] = b0.x; Bi[1] = b0.y; Bi[2] = b0.z; Bi[3] = b0.w; Bi[4] = b1.x; Bi[5] = b1.y; Bi[6] = b1.z; Bi[7] = b1.w; }
#pragma unroll
                for (int e = 0; e < 8; ++e) bl[e] = 0.f;
#pragma unroll
                for (int q = 0; q < 4; ++q) {
                    const f32x4 t0 = *(const LAS f32x4*)(QT + q * 128 + 8 * c8), t1 = *(const LAS f32x4*)(QT + q * 128 + 8 * c8 + 4);
                    const float tv[8] = {t0.x, t0.y, t0.z, t0.w, t1.x, t1.y, t1.z, t1.w};
#pragma unroll
                    for (int e = 0; e < 8; ++e) { bl[e] += tv[e]; Bi[e] += (q < tqq) ? tv[e] : 0.f; }
                }
                const v4u kraw = *(const v4u*)(P5 + (row0 + t) * P5W + P5_GK + hd * GDK + 8 * c8);
                const unsigned kw[4] = {kraw.x, kraw.y, kraw.z, kraw.w};
                const unsigned ad = (unsigned)(t >> 5) * 8192u + off_a((unsigned)(t & 31), (unsigned)c8);
                v4u o;
                { unsigned ow[4];
#pragma unroll
                  for (int e = 0; e < 4; ++e) ow[e] = cvtpk(bf2f(kw[e] & 0xffff) * __builtin_amdgcn_exp2f(bl[2 * e] - Bi[2 * e]), bf2f(kw[e] >> 16) * __builtin_amdgcn_exp2f(bl[2 * e + 1] - Bi[2 * e + 1]));
                  o.x = ow[0]; o.y = ow[1]; o.z = ow[2]; o.w = ow[3]; *(LAS v4u*)(L + GL_KH + ad) = o; }
                if (OUT) {
                    const v4u qraw = *(const v4u*)(P5 + (row0 + t) * P5W + P5_GQ + hd * GDK + 8 * c8);
                    const unsigned qw[4] = {qraw.x, qraw.y, qraw.z, qraw.w};
                    unsigned ow[4];
#pragma unroll
                    for (int e = 0; e < 4; ++e) ow[e] = cvtpk(bf2f(kw[e] & 0xffff) * __builtin_amdgcn_exp2f(-Bi[2 * e]), bf2f(kw[e] >> 16) * __builtin_amdgcn_exp2f(-Bi[2 * e + 1]));
                    o.x = ow[0]; o.y = ow[1]; o.z = ow[2]; o.w = ow[3]; *(LAS v4u*)(L + GL_KI + ad) = o;
#pragma unroll
                    for (int e = 0; e < 4; ++e) ow[e] = cvtpk(bf2f(qw[e] & 0xffff) * __builtin_amdgcn_exp2f(Bi[2 * e]), bf2f(qw[e] >> 16) * __builtin_amdgcn_exp2f(Bi[2 * e + 1]));
                    o.x = ow[0]; o.y = ow[1]; o.z = ow[2]; o.w = ow[3]; *(LAS v4u*)(L + GL_QI + ad) = o;
                }
                if (i2 == 0 && tid < 16) {
#pragma unroll
                    for (int e = 0; e < 8; ++e) { DV[8 * c8 + e] = __builtin_amdgcn_exp2f(bl[e]); sumB[e] += bl[e]; }
                }
            }
#pragma unroll
            for (int i = 0; i < 4; ++i) { const int n = tid + 512 * i, row = n >> 5, ch32 = n & 31;
                const v4u v = *(const v4u*)(P5 + (row0 + row) * P5W + P5_GV + hd * GDV + 8 * ch32);
                *(LAS v4u*)(L + GL_VI + ((row >> 5) * 2 + (ch32 >> 4)) * 8192 + off_a(row & 31, ch32 & 15)) = v; }
            __syncthreads();
            if (OUT) {
                if (w < 3) {
                    const int tb = (w == 0) ? 0 : 1, sb = (w == 2) ? 1 : 0;
                    f32x16 C;
#pragma unroll
                    for (int i = 0; i < 16; ++i) C[i] = 0.f;
#pragma unroll
                    for (int ks = 0; ks < 8; ++ks) {
                        const bf16x8 af = *(const LAS bf16x8*)(L + GL_KI + sb * 8192 + off_a(r, 2 * ks + h));
                        const bf16x8 bfr = *(const LAS bf16x8*)(L + GL_QI + tb * 8192 + off_a(r, 2 * ks + h));
                        C = MFMA32(af, bfr, C);
                    }
#pragma unroll
                    for (int g = 0; g < 4; ++g) {
                        float v[4];
#pragma unroll
                        for (int e = 0; e < 4; ++e) { const int sl = 8 * g + 4 * h + e; v[e] = (tb != sb || sl <= r) ? C[4 * g + e] : 0.f; }
                        u32x2v o; o.x = cvtpk(v[0], v[1]); o.y = cvtpk(v[2], v[3]);
                        *(LAS u32x2v*)(L + GL_PI + (32 * tb + r) * GL_PSTRIDE + (32 * sb + 8 * g + 4 * h) * 2) = o;
                    }
                    if (w == 0 && sc == 0 && c == 0) {
                        const float* q0 = (const float*)(a.ws + WS_QK0) + b * 1024 + hd * GDK; const float* k0 = q0 + 512;
                        const float c00 = wave_sum(q0[lane] * k0[lane] + q0[lane + 64] * k0[lane + 64]) * 0.08838834764831845f;
                        if (lane == 0) *(LAS unsigned short*)(L + GL_PI) = (unsigned short)(cvtpk(c00, 0.f) & 0xffffu);
                    }
                }
                __syncthreads();
            }
            {
                bf16x8 vf[4];
#pragma unroll
                for (int ks = 0; ks < 4; ++ks) {
                    LAS unsigned char* vb = L + GL_VI + ((ks >> 1) * 2 + dvh) * 8192; const unsigned ch = 4 * cw + 2 * blk + (p4 >> 1);
                    const s16x4 lo = tr_read(vb + off_a(16 * (ks & 1) + 8 * h + q4, ch) + bo);
                    const s16x4 hi = tr_read(vb + off_a(16 * (ks & 1) + 8 * h + 4 + q4, ch) + bo);
                    vf[ks] = cat8(lo, hi);
                }
                f32x16 oacc[2];
                if (OUT) {
#pragma unroll
                    for (int tb = 0; tb < 2; ++tb)
#pragma unroll
                        for (int i = 0; i < 16; ++i) oacc[tb][i] = 0.f;
#pragma unroll
                    for (int k4 = 0; k4 < 4; ++k4)
#pragma unroll
                        for (int s2 = 0; s2 < 2; ++s2) {
                            v4u pk; pk.x = cvtpk(S[k4][8 * s2 + 0], S[k4][8 * s2 + 1]); pk.y = cvtpk(S[k4][8 * s2 + 2], S[k4][8 * s2 + 3]); pk.z = cvtpk(S[k4][8 * s2 + 4], S[k4][8 * s2 + 5]); pk.w = cvtpk(S[k4][8 * s2 + 6], S[k4][8 * s2 + 7]);
                            const bf16x8 sb8 = __builtin_bit_cast(bf16x8, pk);
#pragma unroll
                            for (int tb = 0; tb < 2; ++tb) {
                                const s16x4 a0 = *(const LAS s16x4*)(L + GL_QI + tb * 8192 + off_a(r, 4 * k4 + 2 * s2) + 8 * h);
                                const s16x4 a1 = *(const LAS s16x4*)(L + GL_QI + tb * 8192 + off_a(r, 4 * k4 + 2 * s2 + 1) + 8 * h);
                                oacc[tb] = MFMA32(cat8(a0, a1), sb8, oacc[tb]);
                            }
                            asm volatile("" ::: "memory");
                        }
#pragma unroll
                    for (int tb = 0; tb < 2; ++tb)
#pragma unroll
                        for (int ks = 0; ks < 4; ++ks) {
                            if (tb == 0 && ks >= 2) continue;
                            const bf16x8 pa = *(const LAS bf16x8*)(L + GL_PI + (32 * tb + r) * GL_PSTRIDE + (16 * ks + 8 * h) * 2);
                            oacc[tb] = MFMA32(pa, vf[ks], oacc[tb]);
                        }
                }
#pragma unroll
                for (int k4 = 0; k4 < 4; ++k4) {
#pragma unroll
                    for (int g = 0; g < 4; ++g) { const f32x4 dv4 = *(const LAS f32x4*)(DV + 32 * k4 + 8 * g + 4 * h);
                        S[k4][4 * g + 0] *= dv4.x; S[k4][4 * g + 1] *= dv4.y; S[k4][4 * g + 2] *= dv4.z; S[k4][4 * g + 3] *= dv4.w; }
#pragma unroll
                    for (int ks = 0; ks < 4; ++ks) {
                        LAS unsigned char* kb = L + GL_KH + (ks >> 1) * 8192; const unsigned ch = 4 * k4 + 2 * blk + (p4 >> 1);
                        const s16x4 lo = tr_read(kb + off_a(16 * (ks & 1) + 8 * h + q4, ch) + bo);
                        const s16x4 hi = tr_read(kb + off_a(16 * (ks & 1) + 8 * h + 4 + q4, ch) + bo);
                        S[k4] = MFMA32(cat8(lo, hi), vf[ks], S[k4]);
                    }
                    asm volatile("" ::: "memory");
                }
                __syncthreads();
                if (OUT) {
#pragma unroll
                    for (int tb = 0; tb < 2; ++tb)
#pragma unroll
                        for (int i = 0; i < 16; ++i) OS[(32 * tb + (i & 3) + 8 * (i >> 2) + 4 * h) * GL_OSP + 32 * w + r] = oacc[tb][i];
                    __syncthreads();
#pragma unroll
                    for (int rr = 0; rr < 8; ++rr) {
                        const int t = 8 * w + rr;
                        const f32x4 o = *(const LAS f32x4*)(OS + t * GL_OSP + 4 * lane);
                        const float ss = wave_sum((o.x * o.x + o.y * o.y) + (o.z * o.z + o.w * o.w));
                        const float rstd = __builtin_amdgcn_rsqf(ss * (1.f / GDV) + NORM_EPS);
                        bf16* yp = YG + (row0 + t) * YGW + 1024 + hd * GDV + 4 * lane;
                        const uint2 gg = *(const uint2*)yp;
                        const float g0 = bf2f(gg.x & 0xffff), g1 = bf2f(gg.x >> 16), g2 = bf2f(gg.y & 0xffff), g3 = bf2f(gg.y >> 16);
                        const float y0 = o.x * rstd * nw.x * (g0 * __builtin_amdgcn_rcpf(1.0f + __builtin_amdgcn_exp2f(-g0 * LOG2E)));
                        const float y1 = o.y * rstd * nw.y * (g1 * __builtin_amdgcn_rcpf(1.0f + __builtin_amdgcn_exp2f(-g1 * LOG2E)));
                        const float y2 = o.z * rstd * nw.z * (g2 * __builtin_amdgcn_rcpf(1.0f + __builtin_amdgcn_exp2f(-g2 * LOG2E)));
                        const float y3 = o.w * rstd * nw.w * (g3 * __builtin_amdgcn_rcpf(1.0f + __builtin_amdgcn_exp2f(-g3 * LOG2E)));
                        uint2 yo; yo.x = cvtpk(y0, y1); yo.y = cvtpk(y2, y3);
                        *(uint2*)yp = yo;
                    }
                    __syncthreads();
                }
            }
        }
        if (!OUT) {
#pragma unroll
            for (int k4 = 0; k4 < 4; ++k4)
#pragma unroll
                for (int i = 0; i < 16; ++i) sbase[(size_t)(32 * k4 + (i & 3) + 8 * (i >> 2) + 4 * h0) * GDV] = S[k4][i];
            if (F.tid < 16) {
#pragma unroll
                for (int e = 0; e < 8; ++e) DT[(size_t)(bh * 16 + sc) * GDK + 8 * F.tid + e] = __builtin_amdgcn_exp2f(sumB[e]); }
        }
    }
}

__device__ __forceinline__ void gla_scan(Frame& F, const Args& a) {
    float* LST = (float*)((char*)a.out + GLA_LST_OFF); const float* DT = (const float*)((char*)a.out + GLA_DT_OFF);
    for (int e = ((int)blockIdx.x * NWAVES * 64 + F.tid) * 4; e < 16 * GDK * GDV; e += F.G * NWAVES * 64 * 4) {
        const int bh = e >> 15, rem = e & 32767, dk = rem >> 8;
        f32x4 S = {0.f, 0.f, 0.f, 0.f};
        for (int sc = 0; sc < 16; ++sc) {
            f32x4* p = (f32x4*)(LST + (size_t)(bh * 16 + sc) * (GDK * GDV) + rem);
            if (sc < 15) { const f32x4 Lv = *p; const float d = DT[(size_t)(bh * 16 + sc) * GDK + dk]; *p = S; S = S * d + Lv; }
            else *p = S;
        }
    }
}

__global__ void __launch_bounds__(NWAVES * 64, 2) hybrid_fwd(Args args) {
    extern __shared__ __attribute__((aligned(16))) unsigned char lds[];
    Frame F;
    F.lds = (LAS unsigned char*)lds;
    F.MISC = (volatile LAS unsigned*)(F.lds + MISC_OFF);
    F.tid = threadIdx.x; F.lane = F.tid & 63; F.wave = __builtin_amdgcn_readfirstlane(F.tid >> 6);
    F.G = gridDim.x; { const int bx = blockIdx.x; F.vcu = (F.G % 8 == 0) ? (bx % 8) * (F.G / 8) + bx / 8 : bx; }
    unsigned char* ws = args.ws;
    F.ctl = (gu32*)(ws + WS_CTL);
    for (int u = F.tid; u < (LDS_BYTES - LDSCTL_OFF) / 4; u += NWAVES * 64) ((LAS unsigned*)(F.lds + LDSCTL_OFF))[u] = 0u;
    __syncthreads();
    XcdBarrier bar = xcd_barrier_post((unsigned*)(F.ctl + CW_BAR) + args.li * XCD_BAR_WORDS, F.MISC + 8);
    const int lo = args.ph_lo, hi = args.ph_hi;
#define IN(k) (lo <= (k) && (k) < hi)
#define BOTH(k) (IN(k) && IN((k) + 1))

    if (IN(0)) { p0_prologue(F, args); if (BOTH(0)) xcd_barrier(bar); }

    if (IN(1)) {
        pg8::Gemm g{(const pg8::bf16_t*)args.out, (const pg8::bf16_t*)(ws + WS_WIN), M, NPROJ, D}; pg8::StaticOrder S; S.init(M, NPROJ, F.G, (int)blockIdx.x);
        pg8::EpiProj E{(pg8::bf16_t*)(ws + WS_P5), (pg8::bf16_t*)(ws + WS_YG), (const float*)(ws + WS_RS)};
        pg8::gemm_phase<pg8::EpiProj, pg8::StaticOrder, true, true>(F.lds + RING_OFF, g, S, E);
        if (BOTH(1)) xcd_barrier(bar);
    }

    if (IN(2)) {
        const bf16* P5 = (const bf16*)(ws + WS_P5); bf16* YG = (bf16*)(ws + WS_YG);
        gla_pass<false>(F, args);
        xcd_barrier(bar);
        gla_scan(F, args);
        gla_t0_exact(F, args);
        sb_phase(F, P5, YG, args.in[5]);
        xcd_barrier(bar);
        gla_pass<true>(F, args);
        if (BOTH(2)) xcd_barrier(bar);
    }

    if (IN(3)) {
        pg8::Gemm g{(const pg8::bf16_t*)(ws + WS_YG), (const pg8::bf16_t*)(ws + WS_WOUT), M, D, 2048}; pg8::StaticOrder S; S.init(M, D, F.G, (int)blockIdx.x);
        pg8::EpiF32 E{args.out, D};
        pg8::gemm_phase<pg8::EpiF32, pg8::StaticOrder, true, true>(F.lds + RING_OFF, g, S, E);
        if (BOTH(3)) xcd_barrier(bar);
    }

    if (IN(4)) p4_final(F, args);
#undef IN
#undef BOTH
}

extern "C" void kernel_launch(void* const* d_in, const int* in_sizes, int n_in, void* d_out, int out_size, void* d_ws, size_t ws_size, hipStream_t stream) {
    static int grid = 0;
    if (grid == 0) {
        if (n_in != 9 || in_sizes[0] != M * D || out_size != M * D || ws_size < WS_END) { fprintf(stderr, "kernel_launch: unexpected shapes (n_in %d, in0 %d, out %d, ws %zu)\n", n_in, n_in > 0 ? in_sizes[0] : -1, out_size, ws_size); grid = -1; return; }
        int dev = 0, cus = 0, per_cu = 0;
        if (hipGetDevice(&dev) != hipSuccess || hipDeviceGetAttribute(&cus, hipDeviceAttributeMultiprocessorCount, dev) != hipSuccess) { grid = -1; return; }
        if (hipFuncSetAttribute((const void*)hybrid_fwd, hipFuncAttributeMaxDynamicSharedMemorySize, LDS_BYTES) != hipSuccess) { fprintf(stderr, "kernel_launch: hipFuncSetAttribute failed\n"); grid = -1; return; }
        if (hipOccupancyMaxActiveBlocksPerMultiprocessor(&per_cu, (const void*)hybrid_fwd, NWAVES * 64, LDS_BYTES) != hipSuccess || per_cu < 1) { fprintf(stderr, "kernel_launch: occupancy query says %d blocks per CU\n", per_cu); grid = -1; (void)hipGetLastError(); return; }
        grid = cus;
    }
    if (grid < 0) return;
    (void)hipMemsetAsync((char*)d_ws + WS_CTL, 0, CTL_ZERO_BYTES, stream);
    Args a{};
    for (int i = 0; i < 9; ++i) a.in[i] = (const float*)d_in[i];
    a.out = (float*)d_out; a.ws = (unsigned char*)d_ws;
    a.ph_lo = 0; a.ph_hi = 5; a.li = 0;
    hipLaunchKernelGGL(hybrid_fwd, dim3(grid), dim3(NWAVES * 64), LDS_BYTES, stream, a);
}
```

```cpp
#include <hip/hip_runtime.h>
#include <cstdio>
#include <cstdint>
namespace pg8 {
#define PG8_LAS __attribute__((address_space(3)))
typedef unsigned short bf16_t;
typedef short bf16x8 __attribute__((ext_vector_type(8)));
typedef float f32x4 __attribute__((ext_vector_type(4)));
typedef unsigned u32x4 __attribute__((ext_vector_type(4)));
constexpr int BM = 256, BK = 64, HALF = 128, HTB = HALF * BK * 2  , STAGE_BYTES = 8 * HTB, NXCD = 8, WGM = 8;

__host__ __device__ __forceinline__ int lds_byte(int r, int c) { const int st = (r >> 4) * 2 + (c >> 5), rr = r & 15, cc = c & 31, ob = rr * 64 + cc * 2; return st * 1024 + (ob ^ (((ob >> 9) & 1) << 5)); }
__host__ __device__ __forceinline__ void stage_rc(int b, int& R, int& C) { const int st = b / 1024, sb = b % 1024, swz = sb ^ (((sb >> 9) & 1) << 5); R = (st >> 1) * 16 + swz / 64; C = (st & 1) * 32 + (swz % 64) / 2; }
__host__ __device__ __forceinline__ int perm32(int rho) { const int n = rho >> 4, i = rho & 15; return 8 * (i >> 2) + 4 * n + (i & 3); }

struct Unit { int pm, pn; };
struct Gemm { const bf16_t* A; const bf16_t* Bt; int M, N, K; };

struct StaticOrder {
    int nM, nN, nwg, G, c;
    __host__ __device__ void init(int M, int N, int G_, int c_) { nM = M / BM; nN = N / BM; nwg = nM * nN; G = G_; c = c_; }
    __host__ __device__ bool next(int i, Unit& u) const {
        const long L = (long)i * G + c; if (L >= nwg) return false;
        int wgid = (int)L; { const int q = nwg / NXCD, r = nwg % NXCD, xcd = wgid % NXCD, off = wgid / NXCD; wgid = (xcd < r ? xcd * (q + 1) : r * (q + 1) + (xcd - r) * q) + off; }
        const int nig = WGM * nN, gid = wgid / nig, fm = gid * WGM, gsz = (nM - fm) < WGM ? (nM - fm) : WGM;
        u.pm = fm + ((wgid % nig) % gsz); u.pn = (wgid % nig) / gsz; return true;
    }
    __device__ __forceinline__ void a_ready(const Unit&) const {}
    __device__ __forceinline__ void done(const Unit&) const {}
};

__device__ __forceinline__ unsigned cvt_pk_bf16(float lo, float hi) { unsigned r; asm volatile("v_cvt_pk_bf16_f32 %0, %1, %2" : "=v"(r) : "v"(lo), "v"(hi)); return r; }

struct EpiProj {
    static constexpr bool PERM = true, AFTER_DRAIN = false;
    bf16_t* P5; bf16_t* YG; const float* rs;
    __device__ __forceinline__ void operator()(const f32x4 (&acc)[2][2][4][2], const Unit& u, int wr, int wc, int fr, int fq) const {
        const int row0 = u.pm * BM + wr * 64 + fr; const int pn = u.pn;
        bf16_t* base; int ldc, colt;
        if (pn < 20) { base = P5; ldc = 5120; colt = pn * BM; } else { base = YG; ldc = 2048; colt = (pn - 20) * BM; }
        const float qs = pn < 4 ? 0.12751743f   : ((pn == 12 || pn == 13) ? 0.08838834764831845f : 1.0f);
        const int col0 = colt + wc * 32 + 8 * fq;
#pragma unroll
        for (int ai = 0; ai < 2; ++ai)
#pragma unroll
            for (int m = 0; m < 4; ++m) { const int row = row0 + ai * HALF + m * 16; const float sc = rs[row] * qs; bf16_t* rowp = base + (size_t)row * ldc + col0;
#pragma unroll
                for (int bj = 0; bj < 2; ++bj) { const f32x4 v0 = acc[ai][bj][m][0] * sc, v1 = acc[ai][bj][m][1] * sc;
                    u32x4 w; w.x = cvt_pk_bf16(v0[0], v0[1]); w.y = cvt_pk_bf16(v0[2], v0[3]); w.z = cvt_pk_bf16(v1[0], v1[1]); w.w = cvt_pk_bf16(v1[2], v1[3]);
                    *(u32x4*)(rowp + bj * HALF) = w; } }
    }
};

struct EpiF32 {
    static constexpr bool PERM = false, AFTER_DRAIN = false;
    float* C; int ldc;
    __device__ __forceinline__ void operator()(const f32x4 (&acc)[2][2][4][2], const Unit& u, int wr, int wc, int fr, int fq) const {
        const int row0 = u.pm * BM + wr * 64 + fr, col0 = u.pn * BM + wc * 32 + 4 * fq;
#pragma unroll
        for (int ai = 0; ai < 2; ++ai)
#pragma unroll
            for (int m = 0; m < 4; ++m) { float* rowp = C + (size_t)(row0 + ai * HALF + m * 16) * ldc + col0;
#pragma unroll
                for (int bj = 0; bj < 2; ++bj)
#pragma unroll
                    for (int n = 0; n < 2; ++n) *(f32x4*)(rowp + bj * HALF + n * 16) = acc[ai][bj][m][n]; }
    }
};

template <class Epi, class Sched, bool ALIGN_EPI = false, bool SP2 = false>
__device__ __forceinline__ void gemm_phase(PG8_LAS unsigned char* lds, const Gemm g, const Sched& S, const Epi& E) {
    const int tid = threadIdx.x, wid = __builtin_amdgcn_readfirstlane(tid >> 6), lane = tid & 63, wr = wid >> 2, wc = wid & 3, fr = lane & 15, fq = lane >> 4;
    const int K = g.K, nt = K / BK;
    unsigned voffA[2], voffB[2];
#pragma unroll
    for (int i = 0; i < 2; ++i) { int R, C; stage_rc(tid * 16 + i * 8192, R, C); const int Rb = Epi::PERM ? ((R & ~31) + perm32(R & 31)) : R;
        voffA[i] = (unsigned)(R * K + C) * 2u; voffB[i] = (unsigned)(Rb * K + C) * 2u; }
    const size_t kstep = (size_t)(BK * 2);
    const size_t hstep = (size_t)HALF * K * 2;
    const size_t tstep = 2 * hstep;
    const unsigned ldsw = (unsigned)wid * 1024u;
    const int aoff = lds_byte(wr * 64 + fr, fq * 8), boff = lds_byte(wc * 32 + fr, fq * 8);
#define PG8_SA(b, h) (((b) * 2 + (h)) * HTB)
#define PG8_SB(b, h) ((4 + (b) * 2 + (h)) * HTB)
#define PG8_STAGE(bufoff, gbase, voff) do { _Pragma("unroll") for (int _i = 0; _i < 2; ++_i) \
        __builtin_amdgcn_global_load_lds((const unsigned*)((const char*)(gbase) + (voff)[_i]), (PG8_LAS unsigned*)(lds + (bufoff) + ldsw + _i * 8192), 16, 0, 0); } while (0)
#define PG8_LDA(dst, b, h) do { _Pragma("unroll") for (int m = 0; m < 4; ++m) _Pragma("unroll") for (int k = 0; k < 2; ++k) dst[m][k] = *(const PG8_LAS bf16x8*)(lds + PG8_SA(b, h) + aoff + m * 2048 + k * 1024); } while (0)
#define PG8_LDB(dst, b, h) do { _Pragma("unroll") for (int n = 0; n < 2; ++n) _Pragma("unroll") for (int k = 0; k < 2; ++k) dst[n][k] = *(const PG8_LAS bf16x8*)(lds + PG8_SB(b, h) + boff + n * 2048 + k * 1024); } while (0)
#define PG8_MMA(ai, bj, At, Bt) do { __builtin_amdgcn_s_setprio(1); _Pragma("unroll") for (int m = 0; m < 4; ++m) _Pragma("unroll") for (int n = 0; n < 2; ++n) _Pragma("unroll") for (int k = 0; k < 2; ++k) \
        acc[ai][bj][m][n] = __builtin_amdgcn_mfma_f32_16x16x32_bf16(Bt[n][k], At[m][k], acc[ai][bj][m][n], 0, 0, 0); __builtin_amdgcn_s_setprio(0); } while (0)
#define PG8_WAIT_V(n) asm volatile("s_waitcnt vmcnt(" #n ")" ::: "memory")
#define PG8_WAIT_L(n) asm volatile("s_waitcnt lgkmcnt(" #n ")" ::: "memory")
#define PG8_BAR __builtin_amdgcn_s_barrier()
#define PG8_SCHED __builtin_amdgcn_sched_barrier(0)
    Unit cur, nxt; int ui = 0;
    if (!S.next(0, cur)) return;
    f32x4 acc[2][2][4][2];
#pragma unroll
    for (int a = 0; a < 2; ++a)
#pragma unroll
        for (int b = 0; b < 2; ++b)
#pragma unroll
            for (int m = 0; m < 4; ++m)
#pragma unroll
                for (int n = 0; n < 2; ++n) acc[a][b][m][n] = (f32x4){0.f, 0.f, 0.f, 0.f};
    bf16x8 At[4][2], B0[2][2], B1[2][2];
    const char* cA = (const char*)g.A + (size_t)cur.pm * tstep; const char* cB = (const char*)g.Bt + (size_t)cur.pn * tstep;
    S.a_ready(cur);
    if constexpr (SP2) {
        PG8_STAGE(PG8_SB(0, 0), cB, voffB); PG8_STAGE(PG8_SB(0, 1), cB + hstep, voffB); PG8_STAGE(PG8_SA(0, 0), cA, voffA); PG8_STAGE(PG8_SA(0, 1), cA + hstep, voffA);
        if (wr == 1) PG8_BAR;
        PG8_WAIT_V(2); PG8_BAR;
        PG8_STAGE(PG8_SB(1, 0), cB + kstep, voffB); PG8_STAGE(PG8_SA(1, 0), cA + kstep, voffA); PG8_STAGE(PG8_SB(1, 1), cB + hstep + kstep, voffB);
        PG8_WAIT_V(6); PG8_BAR;
    } else {
        PG8_STAGE(PG8_SB(0, 0), cB, voffB); PG8_STAGE(PG8_SA(0, 0), cA, voffA); PG8_STAGE(PG8_SB(0, 1), cB + hstep, voffB); PG8_STAGE(PG8_SA(0, 1), cA + hstep, voffA);
        if (wr == 1) PG8_BAR;
        PG8_WAIT_V(4); PG8_BAR;
        PG8_STAGE(PG8_SB(1, 0), cB + kstep, voffB); PG8_STAGE(PG8_SA(1, 0), cA + kstep, voffA); PG8_STAGE(PG8_SB(1, 1), cB + hstep + kstep, voffB);
        PG8_WAIT_V(6); PG8_BAR;
    }
    for (;;) {
        const bool has_next = S.next(ui + 1, nxt);
        const char* nA = has_next ? (const char*)g.A + (size_t)nxt.pm * tstep : cA; const char* nB = has_next ? (const char*)g.Bt + (size_t)nxt.pn * tstep : cB;
        for (int t = 0; t < nt; t += 2) {
            const bool last = (t == nt - 2);
            const char* a1 = cA + (size_t)(t + 1) * kstep;
            const char* a2 = last ? nA : cA + (size_t)(t + 2) * kstep; const char* b2 = last ? nB : cB + (size_t)(t + 2) * kstep;
            const char* a3 = a2 + kstep; const char* b3 = b2 + kstep;
            if (last && has_next) S.a_ready(nxt);
            if constexpr (SP2) {
            PG8_LDB(B0, 0, 0); PG8_LDB(B1, 0, 1); PG8_SCHED; PG8_LDA(At, 0, 0); PG8_STAGE(PG8_SA(1, 1), a1 + hstep, voffA);
            PG8_WAIT_V(8); PG8_WAIT_L(0); PG8_BAR; PG8_MMA(0, 0, At, B0); PG8_MMA(0, 1, At, B1); PG8_BAR; PG8_SCHED;
            PG8_LDA(At, 0, 1); PG8_STAGE(PG8_SB(0, 0), b2, voffB); PG8_STAGE(PG8_SB(0, 1), b2 + hstep, voffB); PG8_STAGE(PG8_SA(0, 0), a2, voffA);
            PG8_WAIT_V(8); PG8_WAIT_L(0); PG8_BAR; PG8_MMA(1, 0, At, B0); PG8_MMA(1, 1, At, B1); PG8_BAR; PG8_SCHED;
            PG8_LDB(B0, 1, 0); PG8_LDB(B1, 1, 1); PG8_SCHED; PG8_LDA(At, 1, 0); PG8_STAGE(PG8_SA(0, 1), a2 + hstep, voffA);
            PG8_WAIT_V(8); PG8_WAIT_L(0); PG8_BAR; PG8_MMA(0, 0, At, B0); PG8_MMA(0, 1, At, B1); PG8_BAR; PG8_SCHED;
            PG8_LDA(At, 1, 1); PG8_STAGE(PG8_SB(1, 0), b3, voffB); PG8_STAGE(PG8_SB(1, 1), b3 + hstep, voffB); PG8_STAGE(PG8_SA(1, 0), a3, voffA);
            PG8_WAIT_V(8); PG8_WAIT_L(0); PG8_BAR; PG8_MMA(1, 0, At, B0); PG8_MMA(1, 1, At, B1); PG8_BAR; PG8_SCHED;
            } else {
            PG8_LDB(B0, 0, 0); PG8_SCHED; PG8_LDA(At, 0, 0); PG8_STAGE(PG8_SA(1, 1), a1 + hstep, voffA);
            PG8_WAIT_L(8); PG8_BAR; PG8_WAIT_L(0); PG8_MMA(0, 0, At, B0); PG8_BAR; PG8_SCHED;
            PG8_LDB(B1, 0, 1); PG8_STAGE(PG8_SB(0, 0), b2, voffB);
            PG8_BAR; PG8_WAIT_L(0); PG8_MMA(0, 1, At, B1); PG8_BAR;
            PG8_LDA(At, 0, 1); PG8_STAGE(PG8_SA(0, 0), a2, voffA);
            PG8_BAR; PG8_WAIT_L(0); PG8_MMA(1, 0, At, B0); PG8_BAR; PG8_SCHED;
            PG8_STAGE(PG8_SB(0, 1), b2 + hstep, voffB);
            PG8_WAIT_V(6); PG8_BAR; PG8_MMA(1, 1, At, B1); PG8_BAR;
            PG8_LDB(B0, 1, 0); PG8_SCHED; PG8_LDA(At, 1, 0); PG8_STAGE(PG8_SA(0, 1), a2 + hstep, voffA);
            PG8_WAIT_L(8); PG8_BAR; PG8_WAIT_L(0); PG8_MMA(0, 0, At, B0); PG8_BAR; PG8_SCHED;
            PG8_LDB(B1, 1, 1); PG8_STAGE(PG8_SB(1, 0), b3, voffB);
            PG8_BAR; PG8_WAIT_L(0); PG8_MMA(0, 1, At, B1); PG8_BAR;
            PG8_LDA(At, 1, 1); PG8_STAGE(PG8_SA(1, 0), a3, voffA);
            PG8_BAR; PG8_WAIT_L(0); PG8_MMA(1, 0, At, B0); PG8_BAR; PG8_SCHED;
            PG8_STAGE(PG8_SB(1, 1), b3 + hstep, voffB);
            PG8_WAIT_V(6); PG8_BAR; PG8_MMA(1, 1, At, B1); PG8_BAR;
            }
        }
        if constexpr (ALIGN_EPI) { if (wr == 0) PG8_BAR; }
        if constexpr (!Epi::AFTER_DRAIN) { E(acc, cur, wr, wc, fr, fq); S.done(cur); }
        if (!has_next) break;
#pragma unroll
        for (int a = 0; a < 2; ++a)
#pragma unroll
            for (int b = 0; b < 2; ++b)
#pragma unroll
                for (int m = 0; m < 4; ++m)
#pragma unroll
                    for (int n = 0; n < 2; ++n) acc[a][b][m][n] = (f32x4){0.f, 0.f, 0.f, 0.f};
        cur = nxt; cA = nA; cB = nB; ++ui;
        if constexpr (ALIGN_EPI) { if (wr == 1) PG8_BAR; }
    }
    PG8_WAIT_V(0);
    if constexpr (!ALIGN_EPI) { if (wr == 0) PG8_BAR; }
    PG8_BAR;
    if constexpr (Epi::AFTER_DRAIN) { E.fused(acc, cur, wr, wc, fr, fq, lds, wid, lane); S.done(cur); }
#undef PG8_SA
#undef PG8_SB
#undef PG8_STAGE
#undef PG8_LDA
#undef PG8_LDB
#undef PG8_MMA
#undef PG8_WAIT_V
#undef PG8_WAIT_L
#undef PG8_BAR
#undef PG8_SCHED
}
}
#define GAS __attribute__((address_space(1)))
#define LAS __attribute__((address_space(3)))
typedef unsigned short bf16;
typedef unsigned v4u __attribute__((ext_vector_type(4)));
typedef float f32x4 __attribute__((ext_vector_type(4)));
typedef short bf16x8 __attribute__((ext_vector_type(8)));
typedef GAS unsigned gu32;
typedef GAS unsigned long long gu64;
#define RLX_AGENT __ATOMIC_RELAXED, __HIP_MEMORY_SCOPE_AGENT
#define LDS_WAIT() asm volatile("s_waitcnt lgkmcnt(0)" ::: "memory")
#define VM_WAIT() asm volatile("s_waitcnt vmcnt(0)" ::: "memory")
__device__ __forceinline__ unsigned long long rt() { return __builtin_amdgcn_s_memrealtime(); }
__device__ __forceinline__ unsigned f2bf(float f) { unsigned u = __builtin_bit_cast(unsigned, f); return (u + 0x7fffu + ((u >> 16) & 1u)) >> 16; }
__device__ __forceinline__ unsigned pk2(float lo, float hi) { return f2bf(lo) | (f2bf(hi) << 16); }

#define XB_TMO      128
#define XB_XCNT(j)  (256  + 64 * (j))
#define XB_XSUB(j)  (1280 + 64 * (j))
#define XB_XGEN(j)  (2304 + 64 * (j))
#define XB_TOP      3328
#define XB_TOPGEN   3392
#define XCD_BAR_WORDS 3456
#define XB_SPIN_CAP (1u << 24)

__device__ __forceinline__ unsigned xb_ld(unsigned* p)              { return __hip_atomic_load(p, __ATOMIC_RELAXED, __HIP_MEMORY_SCOPE_AGENT); }
__device__ __forceinline__ unsigned xb_add(unsigned* p, unsigned v) { return __hip_atomic_fetch_add(p, v, __ATOMIC_RELAXED, __HIP_MEMORY_SCOPE_AGENT); }
__device__ __forceinline__ unsigned xb_xcc_id() { return (unsigned)__builtin_amdgcn_s_getreg((3 << 11) | 20) & 0xFu; }
#define XB_SPIN(cond, bar) do { unsigned _sp = 0; while (cond) { __builtin_amdgcn_s_sleep(1); \
    if ((++_sp & 255u) == 0u) { if (xb_ld(&(bar)[XB_TMO])) break; if (_sp > XB_SPIN_CAP) { atomicAdd(&(bar)[XB_TMO], 1u); break; } } } } while (0)

struct XcdBarrier {
    unsigned* bar; unsigned x;
    volatile LAS unsigned* st;
};

__device__ __forceinline__ XcdBarrier xcd_barrier_post(unsigned* bar, volatile LAS unsigned* st) {
    XcdBarrier b; b.bar = bar; b.x = xb_xcc_id(); b.st = st;
    if (threadIdx.x == 0) (void)xb_add(&bar[XB_XCNT(b.x)], 1u);
    return b;
}
__device__ __forceinline__ void xcd_barrier_complete(unsigned* bar, unsigned x, unsigned& nloc, unsigned& nx) {
    const unsigned G = gridDim.x * gridDim.y * gridDim.z;
    unsigned sum, cnt, mine, sp = 0u;
    for (;;) {
        sum = 0u; cnt = 0u; mine = 0u;
#pragma unroll
        for (unsigned j = 0; j < 16; ++j) { const unsigned c = xb_ld(&bar[XB_XCNT(j)]); sum += c; cnt += (c > 0u) ? 1u : 0u; mine = (j == x) ? c : mine; }
        if (sum == G) break;
        __builtin_amdgcn_s_sleep(1);
        if ((++sp & 255u) == 0u) { if (xb_ld(&bar[XB_TMO])) break; if (sp > XB_SPIN_CAP) { atomicAdd(&bar[XB_TMO], 1u); break; } }
    }
    nloc = mine > 0u ? mine : 1u; nx = cnt > 0u ? cnt : 1u;
}

__device__ __forceinline__ void xcd_barrier(const XcdBarrier& b) {
    asm volatile("s_waitcnt vmcnt(0)" ::: "memory");
    __syncthreads();
    if (threadIdx.x == 0) {
        unsigned* bar = b.bar;
        __builtin_amdgcn_s_waitcnt(0);
        unsigned nloc = b.st[0], nx = b.st[1];
        if (nloc == 0u) { xcd_barrier_complete(bar, b.x, nloc, nx); b.st[0] = nloc; b.st[1] = nx; }
        const unsigned old = xb_add(&bar[XB_XSUB(b.x)], 1u);
        const unsigned gen = old / nloc;
        if (old + 1u == (gen + 1u) * nloc) {
            __builtin_amdgcn_fence(__ATOMIC_RELEASE, "agent");
            asm volatile("s_waitcnt vmcnt(0)" ::: "memory");
            const unsigned og = xb_add(&bar[XB_TOP], 1u);
            const unsigned tg = og / nx;
            if (og + 1u == (tg + 1u) * nx) xb_add(&bar[XB_TOPGEN], 1u);
            else XB_SPIN(xb_ld(&bar[XB_TOPGEN]) == tg, bar);
            __builtin_amdgcn_fence(__ATOMIC_ACQUIRE, "agent");
            xb_add(&bar[XB_XGEN(b.x)], 1u);
            asm volatile("s_waitcnt vmcnt(0)" ::: "memory");
        } else {
            XB_SPIN(xb_ld(&bar[XB_XGEN(b.x)]) == gen, bar);
            __builtin_amdgcn_fence(__ATOMIC_ACQUIRE, "agent");
            asm volatile("s_waitcnt vmcnt(0)" ::: "memory");
        }
    }
    __syncthreads();
}

constexpr int NWAVES = 8;
constexpr int BATCH = 4, SEQ = 8192, D = 1024, M = BATCH * SEQ;
constexpr int NIN = 7184, NPROJ = 7168;
constexpr int P5W = 5120, YGW = 2048;
constexpr int P5_SBQ = 0, P5_SBK = 1024, P5_SBV = 2048, P5_GQ = 3072, P5_GK = 3584, P5_GV = 4096;
constexpr int SBH = 8, SBD = 128, GH = 4, GDK = 128, GDV = 256, RANK = 16;
constexpr float NORM_EPS = 1e-6f;

constexpr size_t MiB = 1u << 20;
constexpr size_t WS_CTL = 0, CTL_ZERO_BYTES = 1 * MiB;
constexpr size_t WS_WIN = 2 * MiB;
constexpr size_t WS_WOUT = 16 * MiB;
constexpr size_t WS_RS = 20 * MiB;
constexpr size_t WS_LR = 21 * MiB;
constexpr size_t WS_P5 = 24 * MiB;
constexpr size_t WS_YG = 344 * MiB;
constexpr size_t WS_END = 472 * MiB;
constexpr int CW_BAR = 4096;

constexpr int RING_OFF = 0, RING_BYTES = 131072;
constexpr int LDSCTL_OFF = RING_BYTES, MISC_OFF = LDSCTL_OFF + 320;
constexpr int LDS_BYTES = 147456;

struct Frame {
    LAS unsigned char* lds;
    volatile LAS unsigned* MISC;
    gu32* ctl;
    int tid, lane, wave;
    int vcu, G;
};

__device__ __forceinline__ float wave_sum(float v) {
#pragma unroll
    for (int o = 1; o < 64; o <<= 1) v += __shfl_xor(v, o);
    return v;
}
__device__ __forceinline__ float bf2f(unsigned short b) { return __uint_as_float(((unsigned)b) << 16); }

__device__ __forceinline__ void p0_transpose_item(const float* W, int ldw, int n_src0, const float* kscale, bf16* WT, int K, int n_dst0, int k0, LAS float* scr, int lane) {
    float tv[32];
#pragma unroll
    for (int i = 0; i < 32; ++i) { const int kk = 2 * i + (lane >> 5); tv[i] = W[(size_t)(k0 + kk) * ldw + n_src0 + (lane & 31)]; }
#pragma unroll
    for (int i = 0; i < 32; ++i) { const int kk = 2 * i + (lane >> 5); float v = tv[i]; if (kscale) v *= kscale[k0 + kk]; scr[kk * 33 + (lane & 31)] = v; }
    LDS_WAIT(); asm volatile("" ::: "memory");
    const int c = lane & 7;
#pragma unroll
    for (int j = 0; j < 4; ++j) { const int n = (lane >> 3) + 8 * j; const LAS float* s = scr + (8 * c) * 33 + n;
        v4u o; o.x = pk2(s[0 * 33], s[1 * 33]); o.y = pk2(s[2 * 33], s[3 * 33]); o.z = pk2(s[4 * 33], s[5 * 33]); o.w = pk2(s[6 * 33], s[7 * 33]);
        *(GAS v4u*)(WT + (size_t)(n_dst0 + n) * K + k0 + 8 * c) = o; }
    LDS_WAIT(); asm volatile("" ::: "memory");
}
__device__ __forceinline__ int win_src_col(int n) { return n < 3072 ? n : (n < 5120 ? n + 1024 : (n < 6144 ? n - 2048 : n)); }

struct Args { const float* in[9]; float* out; unsigned char* ws; int ph_lo, ph_hi, li, pad; };

__device__ __forceinline__ void p0_prologue(Frame& F, const Args& a) {
    const float* x = a.in[0]; const float* pre_w = a.in[1]; const float* w_in = a.in[2]; const float* w_out = a.in[7];
    bf16* WinT = (bf16*)(a.ws + WS_WIN); bf16* WoutT = (bf16*)(a.ws + WS_WOUT);
    float* RS = (float*)(a.ws + WS_RS); float* LR = (float*)(a.ws + WS_LR);
    bf16* XB = (bf16*)a.out;
    const int gw = F.vcu * NWAVES + F.wave, NGW = F.G * NWAVES;
    {
        LAS float* scr = (LAS float*)(F.lds + RING_OFF + F.wave * 16384);
        constexpr int I_IN = (D / 64) * (NPROJ / 32), I_OUT = (2048 / 64) * (D / 32);
        for (int it = gw; it < I_IN + I_OUT; it += NGW) {
            if (it < I_IN) { const int nb = it % (NPROJ / 32), kb = it / (NPROJ / 32); p0_transpose_item(w_in, NIN, win_src_col(32 * nb), pre_w, WinT, D, 32 * nb, 64 * kb, scr, F.lane); }
            else { const int r = it - I_IN, nb = r % (D / 32), kb = r / (D / 32); p0_transpose_item(w_out, D, 32 * nb, nullptr, WoutT, 2048, 32 * nb, 64 * kb, scr, F.lane); }
        }
    }
    __syncthreads();
    LAS float* WL = (LAS float*)(F.lds + RING_OFF);
    for (int k = F.tid; k < D; k += NWAVES * 64) {
        const float g = pre_w[k]; const f32x4* src = (const f32x4*)(w_in + (size_t)k * NIN + NPROJ);
#pragma unroll
        for (int q = 0; q < 4; ++q) { const f32x4 w = src[q]; WL[(4 * q + 0) * D + k] = w.x * g; WL[(4 * q + 1) * D + k] = w.y * g; WL[(4 * q + 2) * D + k] = w.z * g; WL[(4 * q + 3) * D + k] = w.w * g; }
    }
    __syncthreads();
    f32x4 nv[4];
    if (gw < M) { const GAS f32x4* xr = (const GAS f32x4*)(x + (size_t)gw * D) + F.lane;
#pragma unroll
        for (int j = 0; j < 4; ++j) nv[j] = xr[64 * j]; }
    for (int m = gw; m < M; m += NGW) {
        f32x4 v[4]; float s = 0.f;
#pragma unroll
        for (int j = 0; j < 4; ++j) v[j] = nv[j];
        if (m + NGW < M) { const GAS f32x4* xr = (const GAS f32x4*)(x + (size_t)(m + NGW) * D) + F.lane;
#pragma unroll
            for (int j = 0; j < 4; ++j) nv[j] = xr[64 * j]; }
#pragma unroll
        for (int j = 0; j < 4; ++j) s += (v[j].x * v[j].x + v[j].y * v[j].y) + (v[j].z * v[j].z + v[j].w * v[j].w);
        const float rstd = 1.0f / sqrtf(wave_sum(s) * (1.f / D) + NORM_EPS);
        GAS unsigned long long* o8 = (GAS unsigned long long*)(XB + (size_t)m * D) + F.lane;
#pragma unroll
        for (int j = 0; j < 4; ++j) o8[64 * j] = (unsigned long long)pk2(v[j].x, v[j].y) | ((unsigned long long)pk2(v[j].z, v[j].w) << 32);
        float p[16];
#pragma unroll
        for (int n = 0; n < 16; ++n) { float acc = 0.f;
#pragma unroll
            for (int j = 0; j < 4; ++j) { const f32x4 w = *(const LAS f32x4*)(WL + n * D + 4 * F.lane + 256 * j); acc += (v[j].x * w.x + v[j].y * w.y) + (v[j].z * w.z + v[j].w * w.w); }
            p[n] = acc; if (n & 1) asm volatile("" ::: "memory"); }
        float q8[8], q4[4], q2[2], q1;
        { const bool hi = (F.lane & 32) != 0;
#pragma unroll
          for (int i = 0; i < 8; ++i) { const float keep = hi ? p[i + 8] : p[i], send = hi ? p[i] : p[i + 8]; q8[i] = keep + __shfl_xor(send, 32); } }
        { const bool hi = (F.lane & 16) != 0;
#pragma unroll
          for (int i = 0; i < 4; ++i) { const float keep = hi ? q8[i + 4] : q8[i], send = hi ? q8[i] : q8[i + 4]; q4[i] = keep + __shfl_xor(send, 16); } }
        { const bool hi = (F.lane & 8) != 0;
#pragma unroll
          for (int i = 0; i < 2; ++i) { const float keep = hi ? q4[i + 2] : q4[i], send = hi ? q4[i] : q4[i + 2]; q2[i] = keep + __shfl_xor(send, 8); } }
        { const bool hi = (F.lane & 4) != 0; const float keep = hi ? q2[1] : q2[0], send = hi ? q2[0] : q2[1]; q1 = keep + __shfl_xor(send, 4); }
        q1 += __shfl_xor(q1, 2); q1 += __shfl_xor(q1, 1);
        if ((F.lane & 3) == 0) { const int n = ((F.lane >> 5) & 1) * 8 + ((F.lane >> 4) & 1) * 4 + ((F.lane >> 3) & 1) * 2 + ((F.lane >> 2) & 1); LR[(size_t)m * RANK + n] = q1 * rstd; }
        if (F.lane == 0) RS[m] = rstd;
    }
}

__device__ __forceinline__ void p4_final(Frame& F, const Args& a) {
    const float* x = a.in[0]; const float* post_w = a.in[8]; float* out = a.out;
    const int gw = F.vcu * NWAVES + F.wave, NGW = F.G * NWAVES;
    f32x4 g[4];
#pragma unroll
    for (int j = 0; j < 4; ++j) g[j] = *((const f32x4*)post_w + F.lane + 64 * j);
    for (int m = gw; m < M; m += NGW) {
        GAS f32x4* yr = (GAS f32x4*)(out + (size_t)m * D) + F.lane; const GAS f32x4* xr = (const GAS f32x4*)(x + (size_t)m * D) + F.lane;
        f32x4 v[4], xv[4]; float s = 0.f;
#pragma unroll
        for (int j = 0; j < 4; ++j) { v[j] = yr[64 * j]; xv[j] = xr[64 * j]; s += (v[j].x * v[j].x + v[j].y * v[j].y) + (v[j].z * v[j].z + v[j].w * v[j].w); }
        const float rstd = 1.0f / sqrtf(wave_sum(s) * (1.f / D) + NORM_EPS);
#pragma unroll
        for (int j = 0; j < 4; ++j) yr[64 * j] = xv[j] + (v[j] * rstd) * g[j];
    }
}

typedef float f32x16 __attribute__((ext_vector_type(16)));
typedef short s16x4 __attribute__((ext_vector_type(4)));
typedef float f32x2_t __attribute__((ext_vector_type(2)));
typedef __bf16 bf16x2_t __attribute__((ext_vector_type(2)));
#define MFMA32(a, b, c) __builtin_amdgcn_mfma_f32_32x32x16_bf16((a), (b), (c), 0, 0, 0)
__device__ __forceinline__ unsigned cvtpk(float lo, float hi) { f32x2_t v = {lo, hi}; bf16x2_t b = __builtin_convertvector(v, bf16x2_t); return __builtin_bit_cast(unsigned, b); }
__device__ __forceinline__ unsigned off_a(unsigned row, unsigned ch) { return 2048u * (row >> 3) + 512u * (ch >> 2) + 64u * (row & 7) + 16u * ((ch & 3) ^ ((row >> 2) & 3)); }
__device__ __forceinline__ s16x4 tr_read(LAS unsigned char* p) { return __builtin_amdgcn_ds_read_tr16_b64_v4i16((LAS s16x4*)p); }
__device__ __forceinline__ bf16x8 cat8(s16x4 lo, s16x4 hi) { return __builtin_shufflevector(lo, hi, 0, 1, 2, 3, 4, 5, 6, 7); }
constexpr float LOG2E = 1.4426950408889634f;

__device__ __forceinline__ void sb_phase(Frame& F, const bf16* __restrict__ P5, bf16* YG, const float* __restrict__ sb_norm_w) {
    LAS unsigned char* vimg = F.lds + RING_OFF + F.wave * 8192;
    const int lane = F.lane, r = lane & 31, h = lane >> 5;
    const int kap = 16 * ((r >> 2) & 1) + 4 * (r >> 3) + (r & 3);
    const unsigned blk = (lane >> 4) & 1, q4 = (lane & 15) >> 2, p4 = lane & 3;
    const int nitem = BATCH * SBH * (SEQ / 32), nw = F.G * NWAVES;
    for (int item = F.vcu * NWAVES + F.wave; item < nitem; item += nw) {
        const int qb = item & 255, hd = (item >> 8) & 7, b = item >> 11;
        const size_t rowq = (size_t)b * SEQ + 32 * qb + r;
        bf16x8 qf[8];
        { const bf16* qp = P5 + rowq * P5W + P5_SBQ + hd * SBD + 8 * h;
#pragma unroll
          for (int s = 0; s < 8; ++s) qf[s] = *(const bf16x8*)(qp + 16 * s); }
        f32x16 O[4];
#pragma unroll
        for (int c = 0; c < 4; ++c)
#pragma unroll
            for (int i = 0; i < 16; ++i) O[c][i] = 0.f;
        float carry = 0.f;
        bf16x8 kf[8]; v4u vst[8];
        { const size_t rowk0 = (size_t)b * SEQ + 32 * qb;
          const bf16* kp = P5 + (rowk0 + kap) * P5W + P5_SBK + hd * SBD + 8 * h;
#pragma unroll
          for (int s = 0; s < 8; ++s) kf[s] = *(const bf16x8*)(kp + 16 * s);
#pragma unroll
          for (int i = 0; i < 8; ++i) { const int n = lane + 64 * i, row = n >> 4, ch = n & 15; vst[i] = *(const v4u*)(P5 + (rowk0 + row) * P5W + P5_SBV + hd * SBD + 8 * ch); } }
        for (int kt = qb; kt >= 0; --kt) {
            f32x16 C;
#pragma unroll
            for (int i = 0; i < 16; ++i) C[i] = 0.f;
#pragma unroll
            for (int s = 0; s < 8; ++s) C = MFMA32(kf[s], qf[s], C);
#pragma unroll
            for (int i = 0; i < 8; ++i) { const int n = lane + 64 * i, row = n >> 4, ch = n & 15; *(LAS v4u*)(vimg + off_a(row, ch)) = vst[i]; }
            if (kt > 0) {
                const size_t rowk0 = (size_t)b * SEQ + 32 * (kt - 1);
                const bf16* kp = P5 + (rowk0 + kap) * P5W + P5_SBK + hd * SBD + 8 * h;
#pragma unroll
                for (int s = 0; s < 8; ++s) kf[s] = *(const bf16x8*)(kp + 16 * s);
#pragma unroll
                for (int i = 0; i < 8; ++i) { const int n = lane + 64 * i, row = n >> 4, ch = n & 15; vst[i] = *(const v4u*)(P5 + (rowk0 + row) * P5W + P5_SBV + hd * SBD + 8 * ch); }
            }
            const int lim = (kt == qb) ? r : 64;
            float aft[16]; float run = 0.f;
#pragma unroll
            for (int i = 15; i >= 0; --i) {
                const float z = C[i];
                const float sp = fmaxf(z, 0.f) + __builtin_amdgcn_logf(1.0f + __builtin_amdgcn_exp2f(-fabsf(z)));
                const bool valid = (16 * h + i) < lim;
                const float lf = valid ? -sp : 0.f;
                C[i] = valid ? (z - sp) : -1000.f;
                aft[i] = run; run += lf;
            }
            const float other = __shfl_xor(run, 32);
            const float base = carry + (h == 0 ? other : 0.f);
            carry += run + other;
            unsigned pw[8];
#pragma unroll
            for (int i = 0; i < 8; ++i) pw[i] = cvtpk(__builtin_amdgcn_exp2f(C[2 * i] + aft[2 * i] + base), __builtin_amdgcn_exp2f(C[2 * i + 1] + aft[2 * i + 1] + base));
            bf16x8 ps[2];
            { const v4u a = {pw[0], pw[1], pw[2], pw[3]}, bb = {pw[4], pw[5], pw[6], pw[7]}; ps[0] = __builtin_bit_cast(bf16x8, a); ps[1] = __builtin_bit_cast(bf16x8, bb); }
#pragma unroll
            for (int c = 0; c < 4; ++c)
#pragma unroll
                for (int ks = 0; ks < 2; ++ks) {
                    const unsigned ch = 4 * c + 2 * blk + (p4 >> 1), bo = 8 * (p4 & 1);
                    const s16x4 lo = tr_read(vimg + off_a(16 * h + 8 * ks + q4, ch) + bo);
                    const s16x4 hi = tr_read(vimg + off_a(16 * h + 8 * ks + 4 + q4, ch) + bo);
                    O[c] = MFMA32(cat8(lo, hi), ps[ks], O[c]);
                }
            if (__all(carry < -160.f)) break;
        }
        float ss = 0.f;
#pragma unroll
        for (int c = 0; c < 4; ++c)
#pragma unroll
            for (int i = 0; i < 16; ++i) ss += O[c][i] * O[c][i];
        ss += __shfl_xor(ss, 32);
        const float rstd = __builtin_amdgcn_rsqf(ss * (1.f / SBD) + NORM_EPS);
        bf16* yrow = YG + rowq * YGW + hd * SBD + 4 * h;
        const float* nwp = sb_norm_w + hd * SBD + 4 * h;
#pragma unroll
        for (int c = 0; c < 4; ++c)
#pragma unroll
            for (int g = 0; g < 4; ++g) {
                const int d0 = 32 * c + 8 * g;
                const uint2 gg = *(const uint2*)(yrow + d0); const f32x4 nw = *(const f32x4*)(nwp + d0);
                const float g0 = bf2f(gg.x & 0xffff), g1 = bf2f(gg.x >> 16), g2 = bf2f(gg.y & 0xffff), g3 = bf2f(gg.y >> 16);
                const float y0 = O[c][4 * g + 0] * rstd * nw.x * (g0 * __builtin_amdgcn_rcpf(1.0f + __builtin_amdgcn_exp2f(-g0 * LOG2E)));
                const float y1 = O[c][4 * g + 1] * rstd * nw.y * (g1 * __builtin_amdgcn_rcpf(1.0f + __builtin_amdgcn_exp2f(-g1 * LOG2E)));
                const float y2 = O[c][4 * g + 2] * rstd * nw.z * (g2 * __builtin_amdgcn_rcpf(1.0f + __builtin_amdgcn_exp2f(-g2 * LOG2E)));
                const float y3 = O[c][4 * g + 3] * rstd * nw.w * (g3 * __builtin_amdgcn_rcpf(1.0f + __builtin_amdgcn_exp2f(-g3 * LOG2E)));
                uint2 o; o.x = cvtpk(y0, y1); o.y = cvtpk(y2, y3);
                *(uint2*)(yrow + d0) = o;
            }
    }
}

constexpr int GL_QI = 0, GL_KI = 16384, GL_KH = 32768, GL_PI = 49152, GL_PSTRIDE = 144, GL_OS = 0, GL_OSP = 260;
constexpr int GL_VI = 58368, GL_BM = 91136, GL_LRS = 123904, GL_QT = 128000, GL_DV = 130048;
static_assert(GL_DV + 512 <= RING_BYTES, "GLA LDS map");
constexpr size_t GLA_LST_OFF = 0, GLA_DT_OFF = 64 * MiB;

typedef unsigned u32x2v __attribute__((ext_vector_type(2)));
__device__ __forceinline__ unsigned short f2bf16(float f) { return (unsigned short)f2bf(f); }
__device__ __forceinline__ unsigned img64(int row, int col) { return (unsigned)(row >> 5) * 8192u + off_a((unsigned)(row & 31), (unsigned)(col >> 3)) + (unsigned)(col & 7) * 2u; }

constexpr size_t WS_QK0 = 23 * MiB;
__device__ __forceinline__ void gla_t0_exact(Frame& F, const Args& a) {
    const float* x = a.in[0]; const float* pre_w = a.in[1]; const float* w_in = a.in[2]; const float* RS = (const float*)(a.ws + WS_RS);
    float* QK0 = (float*)(a.ws + WS_QK0);
    LAS float* red = (LAS float*)(F.lds + RING_OFF + 65536);
    for (int task = (int)blockIdx.x; task < 256; task += F.G) {
        const int kq = task >> 6, b = (task >> 4) & 3, cg = task & 15;
        const float* xr = x + (size_t)b * SEQ * D; const float* wc = w_in + 4096 + cg * 64 + F.lane;
        const int k0 = 256 * kq + 32 * F.wave;
        float acc = 0.f;
#pragma unroll
        for (int k = 0; k < 32; ++k) acc += (xr[k0 + k] * pre_w[k0 + k]) * wc[(size_t)(k0 + k) * NIN];
        red[F.wave * 64 + F.lane] = acc;
        __syncthreads();
        if (F.wave == 0) { float s = 0.f;
#pragma unroll
            for (int w8 = 0; w8 < 8; ++w8) s += red[w8 * 64 + F.lane];
            QK0[(kq * BATCH + b) * 1024 + cg * 64 + F.lane] = s * RS[(size_t)b * SEQ]; }
        __syncthreads();
    }
}

template <bool OUT>
__device__ __forceinline__ void gla_pass(Frame& F, const Args& a) {
    const bf16* P5 = (const bf16*)(a.ws + WS_P5); bf16* YG = (bf16*)(a.ws + WS_YG); const float* LR = (const float*)(a.ws + WS_LR);
    const float* w_alpha2 = a.in[3]; const float* b_alpha2 = a.in[4]; const float* gnw = a.in[6];
    float* LST = (float*)((char*)a.out + GLA_LST_OFF); float* DT = (float*)((char*)a.out + GLA_DT_OFF);
    LAS unsigned char* L = F.lds + RING_OFF;
    LAS float* LRS = (LAS float*)(L + GL_LRS); LAS float* QT = (LAS float*)(L + GL_QT); LAS float* DV = (LAS float*)(L + GL_DV); LAS float* OS = (LAS float*)(L + GL_OS); LAS float* BM = (LAS float*)(L + GL_BM);
    const int w = F.wave, dvh = w >> 2, cw = w & 3;
    for (int item = (int)blockIdx.x; item < 256; item += F.G) {
        const int bh = item >> 4, sc = item & 15, b = bh >> 2, hd = bh & 3;
        if (!OUT && sc == 15) continue;
        f32x16 S[4];
        const int lane0 = F.lane, r0 = lane0 & 31, h0 = lane0 >> 5;
        float* sbase = LST + ((size_t)(bh * 16 + sc) * GDK) * GDV + 32 * w + r0;
        if (OUT && sc > 0) {
#pragma unroll
            for (int k4 = 0; k4 < 4; ++k4)
#pragma unroll
                for (int i = 0; i < 16; ++i) S[k4][i] = sbase[(size_t)(32 * k4 + (i & 3) + 8 * (i >> 2) + 4 * h0) * GDV];
        } else {
#pragma unroll
            for (int k4 = 0; k4 < 4; ++k4)
#pragma unroll
                for (int i = 0; i < 16; ++i) S[k4][i] = 0.f;
        }
        float sumB[8];
#pragma unroll
        for (int e = 0; e < 8; ++e) sumB[e] = 0.f;
        f32x4 nw = {0.f, 0.f, 0.f, 0.f};
        if (OUT) nw = *(const f32x4*)(gnw + hd * GDV + 4 * lane0);
        for (int c = 0; c < 8; ++c) {
            int tid = F.tid; asm volatile("" : "+v"(tid));
            const int lane = tid & 63, r = lane & 31, h = lane >> 5;
            const unsigned blk = (lane >> 4) & 1, q4 = (lane & 15) >> 2, p4 = lane & 3, bo = 8 * (p4 & 1);
            const int dk = tid & 127, tq = __builtin_amdgcn_readfirstlane(tid >> 7);
            const size_t row0 = (size_t)b * SEQ + sc * 512 + c * 64;
            { const f32x2_t v = *(const f32x2_t*)(LR + row0 * RANK + 2 * tid); *(LAS f32x2_t*)(LRS + 2 * tid) = v; }
            float wa[16];
#pragma unroll
            for (int j = 0; j < 16; ++j) wa[j] = w_alpha2[j * 512 + hd * GDK + dk];
            const float ba = b_alpha2[hd * GDK + dk];
            __syncthreads();
            {
                float run = 0.f;
#pragma unroll
                for (int i = 0; i < 16; ++i) {
                    const LAS f32x4* lp = (const LAS f32x4*)(LRS + (16 * tq + i) * RANK);
                    const f32x4 l0 = lp[0], l1 = lp[1], l2 = lp[2], l3 = lp[3];
                    float lg = ba;
                    lg += l0.x * wa[0] + l0.y * wa[1] + l0.z * wa[2] + l0.w * wa[3];
                    lg += l1.x * wa[4] + l1.y * wa[5] + l1.z * wa[6] + l1.w * wa[7];
                    lg += l2.x * wa[8] + l2.y * wa[9] + l2.z * wa[10] + l2.w * wa[11];
                    lg += l3.x * wa[12] + l3.y * wa[13] + l3.z * wa[14] + l3.w * wa[15];
                    const float x2 = lg * LOG2E;
                    const float ls2 = -(fmaxf(-x2, 0.f) + __builtin_amdgcn_logf(1.0f + __builtin_amdgcn_exp2f(-fabsf(x2))));
                    run += ls2 * (1.0f / 16.0f);
                    BM[(16 * tq + i) * 128 + dk] = run;
                    if ((i & 3) == 3) asm volatile("" ::: "memory");
                }
                QT[tq * 128 + dk] = run;
            }
            __syncthreads();
#pragma unroll
            for (int i2 = 0; i2 < 2; ++i2) {
                const int n = tid + 512 * i2, t = n >> 4, c8 = n & 15, tqq = t >> 4;
                float Bi[8], bl[8];
                { const f32x4 b0 = *(const LAS f32x4*)(BM + t * 128 + 8 * c8), b1 = *(const LAS f32x4*)(BM + t * 128 + 8 * c8 + 4);
                  Bi[0] = b0.x; Bi[1] = b0.y; Bi[2] = b0.z; Bi[3] = b0.w; Bi[4] = b1.x; Bi[5] = b1.y; Bi[6] = b1.z; Bi[7] = b1.w; }
#pragma unroll
                for (int e = 0; e < 8; ++e) bl[e] = 0.f;
#pragma unroll
                for (int q = 0; q < 4; ++q) {
                    const f32x4 t0 = *(const LAS f32x4*)(QT + q * 128 + 8 * c8), t1 = *(const LAS f32x4*)(QT + q * 128 + 8 * c8 + 4);
                    const float tv[8] = {t0.x, t0.y, t0.z, t0.w, t1.x, t1.y, t1.z, t1.w};
#pragma unroll
                    for (int e = 0; e < 8; ++e) { bl[e] += tv[e]; Bi[e] += (q < tqq) ? tv[e] : 0.f; }
                }
                const v4u kraw = *(const v4u*)(P5 + (row0 + t) * P5W + P5_GK + hd * GDK + 8 * c8);
                const unsigned kw[4] = {kraw.x, kraw.y, kraw.z, kraw.w};
                const unsigned ad = (unsigned)(t >> 5) * 8192u + off_a((unsigned)(t & 31), (unsigned)c8);
                v4u o;
                { unsigned ow[4];
#pragma unroll
                  for (int e = 0; e < 4; ++e) ow[e] = cvtpk(bf2f(kw[e] & 0xffff) * __builtin_amdgcn_exp2f(bl[2 * e] - Bi[2 * e]), bf2f(kw[e] >> 16) * __builtin_amdgcn_exp2f(bl[2 * e + 1] - Bi[2 * e + 1]));
                  o.x = ow[0]; o.y = ow[1]; o.z = ow[2]; o.w = ow[3]; *(LAS v4u*)(L + GL_KH + ad) = o; }
                if (OUT) {
                    const v4u qraw = *(const v4u*)(P5 + (row0 + t) * P5W + P5_GQ + hd * GDK + 8 * c8);
                    const unsigned qw[4] = {qraw.x, qraw.y, qraw.z, qraw.w};
                    unsigned ow[4];
#pragma unroll
                    for (int e = 0; e < 4; ++e) ow[e] = cvtpk(bf2f(kw[e] & 0xffff) * __builtin_amdgcn_exp2f(-Bi[2 * e]), bf2f(kw[e] >> 16) * __builtin_amdgcn_exp2f(-Bi[2 * e + 1]));
                    o.x = ow[0]; o.y = ow[1]; o.z = ow[2]; o.w = ow[3]; *(LAS v4u*)(L + GL_KI + ad) = o;
#pragma unroll
                    for (int e = 0; e < 4; ++e) ow[e] = cvtpk(bf2f(qw[e] & 0xffff) * __builtin_amdgcn_exp2f(Bi[2 * e]), bf2f(qw[e] >> 16) * __builtin_amdgcn_exp2f(Bi[2 * e + 1]));
                    o.x = ow[0]; o.y = ow[1]; o.z = ow[2]; o.w = ow[3]; *(LAS v4u*)(L + GL_QI + ad) = o;
                }
                if (i2 == 0 && tid < 16) {
#pragma unroll
                    for (int e = 0; e < 8; ++e) { DV[8 * c8 + e] = __builtin_amdgcn_exp2f(bl[e]); sumB[e] += bl[e]; }
                }
            }
#pragma unroll
            for (int i = 0; i < 4; ++i) { const int n = tid + 512 * i, row = n >> 5, ch32 = n & 31;
                const v4u v = *(const v4u*)(P5 + (row0 + row) * P5W + P5_GV + hd * GDV + 8 * ch32);
                *(LAS v4u*)(L + GL_VI + ((row >> 5) * 2 + (ch32 >> 4)) * 8192 + off_a(row & 31, ch32 & 15)) = v; }
            __syncthreads();
            if (OUT) {
                if (w < 3) {
                    const int tb = (w == 0) ? 0 : 1, sb = (w == 2) ? 1 : 0;
                    f32x16 C;
#pragma unroll
                    for (int i = 0; i < 16; ++i) C[i] = 0.f;
#pragma unroll
                    for (int ks = 0; ks < 8; ++ks) {
                        const bf16x8 af = *(const LAS bf16x8*)(L + GL_KI + sb * 8192 + off_a(r, 2 * ks + h));
                        const bf16x8 bfr = *(const LAS bf16x8*)(L + GL_QI + tb * 8192 + off_a(r, 2 * ks + h));
                        C = MFMA32(af, bfr, C);
                    }
#pragma unroll
                    for (int g = 0; g < 4; ++g) {
                        float v[4];
#pragma unroll
                        for (int e = 0; e < 4; ++e) { const int sl = 8 * g + 4 * h + e; v[e] = (tb != sb || sl <= r) ? C[4 * g + e] : 0.f; }
                        u32x2v o; o.x = cvtpk(v[0], v[1]); o.y = cvtpk(v[2], v[3]);
                        *(LAS u32x2v*)(L + GL_PI + (32 * tb + r) * GL_PSTRIDE + (32 * sb + 8 * g + 4 * h) * 2) = o;
                    }
                    if (w == 0 && sc == 0 && c == 0) {
                        const float* q0 = (const float*)(a.ws + WS_QK0) + b * 1024 + hd * GDK;
                        float qa = 0.f, qb2 = 0.f, ka = 0.f, kb2 = 0.f;
#pragma unroll
                        for (int kq = 0; kq < 4; ++kq) { const float* qq = q0 + kq * BATCH * 1024; qa += qq[lane]; qb2 += qq[lane + 64]; ka += qq[512 + lane]; kb2 += qq[512 + lane + 64]; }
                        const float c00 = wave_sum(qa * ka + qb2 * kb2) * 0.08838834764831845f;
                        if (lane == 0) *(LAS unsigned short*)(L + GL_PI) = (unsigned short)(cvtpk(c00, 0.f) & 0xffffu);
                    }
                }
                __syncthreads();
            }
            {
                bf16x8 vf[4];
#pragma unroll
                for (int ks = 0; ks < 4; ++ks) {
                    LAS unsigned char* vb = L + GL_VI + ((ks >> 1) * 2 + dvh) * 8192; const unsigned ch = 4 * cw + 2 * blk + (p4 >> 1);
                    const s16x4 lo = tr_read(vb + off_a(16 * (ks & 1) + 8 * h + q4, ch) + bo);
                    const s16x4 hi = tr_read(vb + off_a(16 * (ks & 1) + 8 * h + 4 + q4, ch) + bo);
                    vf[ks] = cat8(lo, hi);
                }
                f32x16 oacc[2];
                if (OUT) {
#pragma unroll
                    for (int tb = 0; tb < 2; ++tb)
#pragma unroll
                        for (int i = 0; i < 16; ++i) oacc[tb][i] = 0.f;
#pragma unroll
                    for (int k4 = 0; k4 < 4; ++k4)
#pragma unroll
                        for (int s2 = 0; s2 < 2; ++s2) {
                            v4u pk; pk.x = cvtpk(S[k4][8 * s2 + 0], S[k4][8 * s2 + 1]); pk.y = cvtpk(S[k4][8 * s2 + 2], S[k4][8 * s2 + 3]); pk.z = cvtpk(S[k4][8 * s2 + 4], S[k4][8 * s2 + 5]); pk.w = cvtpk(S[k4][8 * s2 + 6], S[k4][8 * s2 + 7]);
                            const bf16x8 sb8 = __builtin_bit_cast(bf16x8, pk);
#pragma unroll
                            for (int tb = 0; tb < 2; ++tb) {
                                const s16x4 a0 = *(const LAS s16x4*)(L + GL_QI + tb * 8192 + off_a(r, 4 * k4 + 2 * s2) + 8 * h);
                                const s16x4 a1 = *(const LAS s16x4*)(L + GL_QI + tb * 8192 + off_a(r, 4 * k4 + 2 * s2 + 1) + 8 * h);
                                oacc[tb] = MFMA32(cat8(a0, a1), sb8, oacc[tb]);
                            }
                            asm volatile("" ::: "memory");
                        }
#pragma unroll
                    for (int tb = 0; tb < 2; ++tb)
#pragma unroll
                        for (int ks = 0; ks < 4; ++ks) {
                            if (tb == 0 && ks >= 2) continue;
                            const bf16x8 pa = *(const LAS bf16x8*)(L + GL_PI + (32 * tb + r) * GL_PSTRIDE + (16 * ks + 8 * h) * 2);
                            oacc[tb] = MFMA32(pa, vf[ks], oacc[tb]);
                        }
                }
#pragma unroll
                for (int k4 = 0; k4 < 4; ++k4) {
#pragma unroll
                    for (int g = 0; g < 4; ++g) { const f32x4 dv4 = *(const LAS f32x4*)(DV + 32 * k4 + 8 * g + 4 * h);
                        S[k4][4 * g + 0] *= dv4.x; S[k4][4 * g + 1] *= dv4.y; S[k4][4 * g + 2] *= dv4.z; S[k4][4 * g + 3] *= dv4.w; }
#pragma unroll
                    for (int ks = 0; ks < 4; ++ks) {
                        LAS unsigned char* kb = L + GL_KH + (ks >> 1) * 8192; const unsigned ch = 4 * k4 + 2 * blk + (p4 >> 1);
                        const s16x4 lo = tr_read(kb + off_a(16 * (ks & 1) + 8 * h + q4, ch) + bo);
                        const s16x4 hi = tr_read(kb + off_a(16 * (ks & 1) + 8 * h + 4 + q4, ch) + bo);
                        S[k4] = MFMA32(cat8(lo, hi), vf[ks], S[k4]);
                    }
                    asm volatile("" ::: "memory");
                }
                __syncthreads();
                if (OUT) {
#pragma unroll
                    for (int tb = 0; tb < 2; ++tb)
#pragma unroll
                        for (int i = 0; i < 16; ++i) OS[(32 * tb + (i & 3) + 8 * (i >> 2) + 4 * h) * GL_OSP + 32 * w + r] = oacc[tb][i];
                    __syncthreads();
#pragma unroll
                    for (int rr = 0; rr < 8; ++rr) {
                        const int t = 8 * w + rr;
                        const f32x4 o = *(const LAS f32x4*)(OS + t * GL_OSP + 4 * lane);
                        const float ss = wave_sum((o.x * o.x + o.y * o.y) + (o.z * o.z + o.w * o.w));
                        const float rstd = __builtin_amdgcn_rsqf(ss * (1.f / GDV) + NORM_EPS);
                        bf16* yp = YG + (row0 + t) * YGW + 1024 + hd * GDV + 4 * lane;
                        const uint2 gg = *(const uint2*)yp;
                        const float g0 = bf2f(gg.x & 0xffff), g1 = bf2f(gg.x >> 16), g2 = bf2f(gg.y & 0xffff), g3 = bf2f(gg.y >> 16);
                        const float y0 = o.x * rstd * nw.x * (g0 * __builtin_amdgcn_rcpf(1.0f + __builtin_amdgcn_exp2f(-g0 * LOG2E)));
                        const float y1 = o.y * rstd * nw.y * (g1 * __builtin_amdgcn_rcpf(1.0f + __builtin_amdgcn_exp2f(-g1 * LOG2E)));
                        const float y2 = o.z * rstd * nw.z * (g2 * __builtin_amdgcn_rcpf(1.0f + __builtin_amdgcn_exp2f(-g2 * LOG2E)));
                        const float y3 = o.w * rstd * nw.w * (g3 * __builtin_amdgcn_rcpf(1.0f + __builtin_amdgcn_exp2f(-g3 * LOG2E)));
                        uint2 yo; yo.x = cvtpk(y0, y1); yo.y = cvtpk(y2, y3);
                        *(uint2*)yp = yo;
                    }
                    __syncthreads();
                }
            }
        }
        if (!OUT) {
#pragma unroll
            for (int k4 = 0; k4 < 4; ++k4)
#pragma unroll
                for (int i = 0; i < 16; ++i) sbase[(size_t)(32 * k4 + (i & 3) + 8 * (i >> 2) + 4 * h0) * GDV] = S[k4][i];
            if (F.tid < 16) {
#pragma unroll
                for (int e = 0; e < 8; ++e) DT[(size_t)(bh * 16 + sc) * GDK + 8 * F.tid + e] = __builtin_amdgcn_exp2f(sumB[e]); }
        }
    }
}

__device__ __forceinline__ void gla_scan(Frame& F, const Args& a) {
    float* LST = (float*)((char*)a.out + GLA_LST_OFF); const float* DT = (const float*)((char*)a.out + GLA_DT_OFF);
    for (int e = ((int)blockIdx.x * NWAVES * 64 + F.tid) * 4; e < 16 * GDK * GDV; e += F.G * NWAVES * 64 * 4) {
        const int bh = e >> 15, rem = e & 32767, dk = rem >> 8;
        f32x4* p = (f32x4*)(LST + (size_t)(bh * 16) * (GDK * GDV) + rem);
        const float* dp = DT + (size_t)(bh * 16) * GDK + dk;
        f32x4 Lv[15]; float d[15];
#pragma unroll
        for (int sc = 0; sc < 15; ++sc) { Lv[sc] = p[(size_t)sc * (GDK * GDV / 4)]; d[sc] = dp[sc * GDK]; }
        f32x4 S = {0.f, 0.f, 0.f, 0.f};
#pragma unroll
        for (int sc = 0; sc < 16; ++sc) { p[(size_t)sc * (GDK * GDV / 4)] = S; if (sc < 15) S = S * d[sc] + Lv[sc]; }
    }
}

__global__ void __launch_bounds__(NWAVES * 64, 2) hybrid_fwd(Args args) {
    extern __shared__ __attribute__((aligned(16))) unsigned char lds[];
    Frame F;
    F.lds = (LAS unsigned char*)lds;
    F.MISC = (volatile LAS unsigned*)(F.lds + MISC_OFF);
    F.tid = threadIdx.x; F.lane = F.tid & 63; F.wave = __builtin_amdgcn_readfirstlane(F.tid >> 6);
    F.G = gridDim.x; { const int bx = blockIdx.x; F.vcu = (F.G % 8 == 0) ? (bx % 8) * (F.G / 8) + bx / 8 : bx; }
    unsigned char* ws = args.ws;
    F.ctl = (gu32*)(ws + WS_CTL);
    for (int u = F.tid; u < (LDS_BYTES - LDSCTL_OFF) / 4; u += NWAVES * 64) ((LAS unsigned*)(F.lds + LDSCTL_OFF))[u] = 0u;
    __syncthreads();
    XcdBarrier bar = xcd_barrier_post((unsigned*)(F.ctl + CW_BAR) + args.li * XCD_BAR_WORDS, F.MISC + 8);
    const int lo = args.ph_lo, hi = args.ph_hi;
#define IN(k) (lo <= (k) && (k) < hi)
#define BOTH(k) (IN(k) && IN((k) + 1))

    if (IN(0)) { p0_prologue(F, args); if (BOTH(0)) xcd_barrier(bar); }

    if (IN(1)) {
        pg8::Gemm g{(const pg8::bf16_t*)args.out, (const pg8::bf16_t*)(ws + WS_WIN), M, NPROJ, D}; pg8::StaticOrder S; S.init(M, NPROJ, F.G, (int)blockIdx.x);
        pg8::EpiProj E{(pg8::bf16_t*)(ws + WS_P5), (pg8::bf16_t*)(ws + WS_YG), (const float*)(ws + WS_RS)};
        pg8::gemm_phase<pg8::EpiProj, pg8::StaticOrder, true, true>(F.lds + RING_OFF, g, S, E);
        if (BOTH(1)) xcd_barrier(bar);
    }

    if (IN(2)) {
        const bf16* P5 = (const bf16*)(ws + WS_P5); bf16* YG = (bf16*)(ws + WS_YG);
        gla_pass<false>(F, args);
        xcd_barrier(bar);
        gla_scan(F, args);
        gla_t0_exact(F, args);
        sb_phase(F, P5, YG, args.in[5]);
        xcd_barrier(bar);
        gla_pass<true>(F, args);
        if (BOTH(2)) xcd_barrier(bar);
    }

    if (IN(3)) {
        pg8::Gemm g{(const pg8::bf16_t*)(ws + WS_YG), (const pg8::bf16_t*)(ws + WS_WOUT), M, D, 2048}; pg8::StaticOrder S; S.init(M, D, F.G, (int)blockIdx.x);
        pg8::EpiF32 E{args.out, D};
        pg8::gemm_phase<pg8::EpiF32, pg8::StaticOrder, true, true>(F.lds + RING_OFF, g, S, E);
        if (BOTH(3)) xcd_barrier(bar);
    }

    if (IN(4)) p4_final(F, args);
#undef IN
#undef BOTH
}

extern "C" void kernel_launch(void* const* d_in, const int* in_sizes, int n_in, void* d_out, int out_size, void* d_ws, size_t ws_size, hipStream_t stream) {
    static int grid = 0;
    if (grid == 0) {
        if (n_in != 9 || in_sizes[0] != M * D || out_size != M * D || ws_size < WS_END) { fprintf(stderr, "kernel_launch: unexpected shapes (n_in %d, in0 %d, out %d, ws %zu)\n", n_in, n_in > 0 ? in_sizes[0] : -1, out_size, ws_size); grid = -1; return; }
        int dev = 0, cus = 0, per_cu = 0;
        if (hipGetDevice(&dev) != hipSuccess || hipDeviceGetAttribute(&cus, hipDeviceAttributeMultiprocessorCount, dev) != hipSuccess) { grid = -1; return; }
        if (hipFuncSetAttribute((const void*)hybrid_fwd, hipFuncAttributeMaxDynamicSharedMemorySize, LDS_BYTES) != hipSuccess) { fprintf(stderr, "kernel_launch: hipFuncSetAttribute failed\n"); grid = -1; return; }
        if (hipOccupancyMaxActiveBlocksPerMultiprocessor(&per_cu, (const void*)hybrid_fwd, NWAVES * 64, LDS_BYTES) != hipSuccess || per_cu < 1) { fprintf(stderr, "kernel_launch: occupancy query says %d blocks per CU\n", per_cu); grid = -1; (void)hipGetLastError(); return; }
        grid = cus;
    }
    if (grid < 0) return;
    (void)hipMemsetAsync((char*)d_ws + WS_CTL, 0, CTL_ZERO_BYTES, stream);
    Args a{};
    for (int i = 0; i < 9; ++i) a.in[i] = (const float*)d_in[i];
    a.out = (float*)d_out; a.ws = (unsigned char*)d_ws;
    a.ph_lo = 0; a.ph_hi = 5; a.li = 0;
    hipLaunchKernelGGL(hybrid_fwd, dim3(grid), dim3(NWAVES * 64), LDS_BYTES, stream, a);
}
```

```cpp
#include <hip/hip_runtime.h>
#include <cstdio>
#include <cstdint>
namespace pg8 {
#define PG8_LAS __attribute__((address_space(3)))
typedef unsigned short bf16_t;
typedef short bf16x8 __attribute__((ext_vector_type(8)));
typedef float f32x4 __attribute__((ext_vector_type(4)));
typedef unsigned u32x4 __attribute__((ext_vector_type(4)));
constexpr int BM = 256, BK = 64, HALF = 128, HTB = HALF * BK * 2  , STAGE_BYTES = 8 * HTB, NXCD = 8, WGM = 8;

__host__ __device__ __forceinline__ int lds_byte(int r, int c) { const int st = (r >> 4) * 2 + (c >> 5), rr = r & 15, cc = c & 31, ob = rr * 64 + cc * 2; return st * 1024 + (ob ^ (((ob >> 9) & 1) << 5)); }
__host__ __device__ __forceinline__ void stage_rc(int b, int& R, int& C) { const int st = b / 1024, sb = b % 1024, swz = sb ^ (((sb >> 9) & 1) << 5); R = (st >> 1) * 16 + swz / 64; C = (st & 1) * 32 + (swz % 64) / 2; }
__host__ __device__ __forceinline__ int perm32(int rho) { const int n = rho >> 4, i = rho & 15; return 8 * (i >> 2) + 4 * n + (i & 3); }

struct Unit { int pm, pn; };
struct Gemm { const bf16_t* A; const bf16_t* Bt; int M, N, K; };

struct StaticOrder {
    int nM, nN, nwg, G, c;
    __host__ __device__ void init(int M, int N, int G_, int c_) { nM = M / BM; nN = N / BM; nwg = nM * nN; G = G_; c = c_; }
    __host__ __device__ bool next(int i, Unit& u) const {
        const long L = (long)i * G + c; if (L >= nwg) return false;
        int wgid = (int)L; { const int q = nwg / NXCD, r = nwg % NXCD, xcd = wgid % NXCD, off = wgid / NXCD; wgid = (xcd < r ? xcd * (q + 1) : r * (q + 1) + (xcd - r) * q) + off; }
        const int nig = WGM * nN, gid = wgid / nig, fm = gid * WGM, gsz = (nM - fm) < WGM ? (nM - fm) : WGM;
        u.pm = fm + ((wgid % nig) % gsz); u.pn = (wgid % nig) / gsz; return true;
    }
    __device__ __forceinline__ void a_ready(const Unit&) const {}
    __device__ __forceinline__ void done(const Unit&) const {}
};

__device__ __forceinline__ unsigned cvt_pk_bf16(float lo, float hi) { unsigned r; asm volatile("v_cvt_pk_bf16_f32 %0, %1, %2" : "=v"(r) : "v"(lo), "v"(hi)); return r; }

struct EpiProj {
    static constexpr bool PERM = true, AFTER_DRAIN = false;
    bf16_t* P5; bf16_t* YG; const float* rs;
    __device__ __forceinline__ void operator()(const f32x4 (&acc)[2][2][4][2], const Unit& u, int wr, int wc, int fr, int fq) const {
        const int row0 = u.pm * BM + wr * 64 + fr; const int pn = u.pn;
        bf16_t* base; int ldc, colt;
        if (pn < 20) { base = P5; ldc = 5120; colt = pn * BM; } else { base = YG; ldc = 2048; colt = (pn - 20) * BM; }
        const float qs = pn < 4 ? 0.12751743f   : ((pn == 12 || pn == 13) ? 0.08838834764831845f : 1.0f);
        const int col0 = colt + wc * 32 + 8 * fq;
#pragma unroll
        for (int ai = 0; ai < 2; ++ai)
#pragma unroll
            for (int m = 0; m < 4; ++m) { const int row = row0 + ai * HALF + m * 16; const float sc = rs[row] * qs; bf16_t* rowp = base + (size_t)row * ldc + col0;
#pragma unroll
                for (int bj = 0; bj < 2; ++bj) { const f32x4 v0 = acc[ai][bj][m][0] * sc, v1 = acc[ai][bj][m][1] * sc;
                    u32x4 w; w.x = cvt_pk_bf16(v0[0], v0[1]); w.y = cvt_pk_bf16(v0[2], v0[3]); w.z = cvt_pk_bf16(v1[0], v1[1]); w.w = cvt_pk_bf16(v1[2], v1[3]);
                    *(u32x4*)(rowp + bj * HALF) = w; } }
    }
};

struct EpiF32 {
    static constexpr bool PERM = false, AFTER_DRAIN = false;
    float* C; int ldc;
    __device__ __forceinline__ void operator()(const f32x4 (&acc)[2][2][4][2], const Unit& u, int wr, int wc, int fr, int fq) const {
        const int row0 = u.pm * BM + wr * 64 + fr, col0 = u.pn * BM + wc * 32 + 4 * fq;
#pragma unroll
        for (int ai = 0; ai < 2; ++ai)
#pragma unroll
            for (int m = 0; m < 4; ++m) { float* rowp = C + (size_t)(row0 + ai * HALF + m * 16) * ldc + col0;
#pragma unroll
                for (int bj = 0; bj < 2; ++bj)
#pragma unroll
                    for (int n = 0; n < 2; ++n) *(f32x4*)(rowp + bj * HALF + n * 16) = acc[ai][bj][m][n]; }
    }
};

template <class Epi, class Sched, bool ALIGN_EPI = false, bool SP2 = false>
__device__ __forceinline__ void gemm_phase(PG8_LAS unsigned char* lds, const Gemm g, const Sched& S, const Epi& E) {
    const int tid = threadIdx.x, wid = __builtin_amdgcn_readfirstlane(tid >> 6), lane = tid & 63, wr = wid >> 2, wc = wid & 3, fr = lane & 15, fq = lane >> 4;
    const int K = g.K, nt = K / BK;
    unsigned voffA[2], voffB[2];
#pragma unroll
    for (int i = 0; i < 2; ++i) { int R, C; stage_rc(tid * 16 + i * 8192, R, C); const int Rb = Epi::PERM ? ((R & ~31) + perm32(R & 31)) : R;
        voffA[i] = (unsigned)(R * K + C) * 2u; voffB[i] = (unsigned)(Rb * K + C) * 2u; }
    const size_t kstep = (size_t)(BK * 2);
    const size_t hstep = (size_t)HALF * K * 2;
    const size_t tstep = 2 * hstep;
    const unsigned ldsw = (unsigned)wid * 1024u;
    const int aoff = lds_byte(wr * 64 + fr, fq * 8), boff = lds_byte(wc * 32 + fr, fq * 8);
#define PG8_SA(b, h) (((b) * 2 + (h)) * HTB)
#define PG8_SB(b, h) ((4 + (b) * 2 + (h)) * HTB)
#define PG8_STAGE(bufoff, gbase, voff) do { _Pragma("unroll") for (int _i = 0; _i < 2; ++_i) \
        __builtin_amdgcn_global_load_lds((const unsigned*)((const char*)(gbase) + (voff)[_i]), (PG8_LAS unsigned*)(lds + (bufoff) + ldsw + _i * 8192), 16, 0, 0); } while (0)
#define PG8_LDA(dst, b, h) do { _Pragma("unroll") for (int m = 0; m < 4; ++m) _Pragma("unroll") for (int k = 0; k < 2; ++k) dst[m][k] = *(const PG8_LAS bf16x8*)(lds + PG8_SA(b, h) + aoff + m * 2048 + k * 1024); } while (0)
#define PG8_LDB(dst, b, h) do { _Pragma("unroll") for (int n = 0; n < 2; ++n) _Pragma("unroll") for (int k = 0; k < 2; ++k) dst[n][k] = *(const PG8_LAS bf16x8*)(lds + PG8_SB(b, h) + boff + n * 2048 + k * 1024); } while (0)
#define PG8_MMA(ai, bj, At, Bt) do { __builtin_amdgcn_s_setprio(1); _Pragma("unroll") for (int m = 0; m < 4; ++m) _Pragma("unroll") for (int n = 0; n < 2; ++n) _Pragma("unroll") for (int k = 0; k < 2; ++k) \
        acc[ai][bj][m][n] = __builtin_amdgcn_mfma_f32_16x16x32_bf16(Bt[n][k], At[m][k], acc[ai][bj][m][n], 0, 0, 0); __builtin_amdgcn_s_setprio(0); } while (0)
#define PG8_WAIT_V(n) asm volatile("s_waitcnt vmcnt(" #n ")" ::: "memory")
#define PG8_WAIT_L(n) asm volatile("s_waitcnt lgkmcnt(" #n ")" ::: "memory")
#define PG8_BAR __builtin_amdgcn_s_barrier()
#define PG8_SCHED __builtin_amdgcn_sched_barrier(0)
    Unit cur, nxt; int ui = 0;
    if (!S.next(0, cur)) return;
    f32x4 acc[2][2][4][2];
#pragma unroll
    for (int a = 0; a < 2; ++a)
#pragma unroll
        for (int b = 0; b < 2; ++b)
#pragma unroll
            for (int m = 0; m < 4; ++m)
#pragma unroll
                for (int n = 0; n < 2; ++n) acc[a][b][m][n] = (f32x4){0.f, 0.f, 0.f, 0.f};
    bf16x8 At[4][2], B0[2][2], B1[2][2];
    const char* cA = (const char*)g.A + (size_t)cur.pm * tstep; const char* cB = (const char*)g.Bt + (size_t)cur.pn * tstep;
    S.a_ready(cur);
    if constexpr (SP2) {
        PG8_STAGE(PG8_SB(0, 0), cB, voffB); PG8_STAGE(PG8_SB(0, 1), cB + hstep, voffB); PG8_STAGE(PG8_SA(0, 0), cA, voffA); PG8_STAGE(PG8_SA(0, 1), cA + hstep, voffA);
        if (wr == 1) PG8_BAR;
        PG8_WAIT_V(2); PG8_BAR;
        PG8_STAGE(PG8_SB(1, 0), cB + kstep, voffB); PG8_STAGE(PG8_SA(1, 0), cA + kstep, voffA); PG8_STAGE(PG8_SB(1, 1), cB + hstep + kstep, voffB);
        PG8_WAIT_V(6); PG8_BAR;
    } else {
        PG8_STAGE(PG8_SB(0, 0), cB, voffB); PG8_STAGE(PG8_SA(0, 0), cA, voffA); PG8_STAGE(PG8_SB(0, 1), cB + hstep, voffB); PG8_STAGE(PG8_SA(0, 1), cA + hstep, voffA);
        if (wr == 1) PG8_BAR;
        PG8_WAIT_V(4); PG8_BAR;
        PG8_STAGE(PG8_SB(1, 0), cB + kstep, voffB); PG8_STAGE(PG8_SA(1, 0), cA + kstep, voffA); PG8_STAGE(PG8_SB(1, 1), cB + hstep + kstep, voffB);
        PG8_WAIT_V(6); PG8_BAR;
    }
    for (;;) {
        const bool has_next = S.next(ui + 1, nxt);
        const char* nA = has_next ? (const char*)g.A + (size_t)nxt.pm * tstep : cA; const char* nB = has_next ? (const char*)g.Bt + (size_t)nxt.pn * tstep : cB;
        for (int t = 0; t < nt; t += 2) {
            const bool last = (t == nt - 2);
            const char* a1 = cA + (size_t)(t + 1) * kstep;
            const char* a2 = last ? nA : cA + (size_t)(t + 2) * kstep; const char* b2 = last ? nB : cB + (size_t)(t + 2) * kstep;
            const char* a3 = a2 + kstep; const char* b3 = b2 + kstep;
            if (last && has_next) S.a_ready(nxt);
            if constexpr (SP2) {
            PG8_LDB(B0, 0, 0); PG8_LDB(B1, 0, 1); PG8_SCHED; PG8_LDA(At, 0, 0); PG8_STAGE(PG8_SA(1, 1), a1 + hstep, voffA);
            PG8_WAIT_V(8); PG8_WAIT_L(0); PG8_BAR; PG8_MMA(0, 0, At, B0); PG8_MMA(0, 1, At, B1); PG8_BAR; PG8_SCHED;
            PG8_LDA(At, 0, 1); PG8_STAGE(PG8_SB(0, 0), b2, voffB); PG8_STAGE(PG8_SB(0, 1), b2 + hstep, voffB); PG8_STAGE(PG8_SA(0, 0), a2, voffA);
            PG8_WAIT_V(8); PG8_WAIT_L(0); PG8_BAR; PG8_MMA(1, 0, At, B0); PG8_MMA(1, 1, At, B1); PG8_BAR; PG8_SCHED;
            PG8_LDB(B0, 1, 0); PG8_LDB(B1, 1, 1); PG8_SCHED; PG8_LDA(At, 1, 0); PG8_STAGE(PG8_SA(0, 1), a2 + hstep, voffA);
            PG8_WAIT_V(8); PG8_WAIT_L(0); PG8_BAR; PG8_MMA(0, 0, At, B0); PG8_MMA(0, 1, At, B1); PG8_BAR; PG8_SCHED;
            PG8_LDA(At, 1, 1); PG8_STAGE(PG8_SB(1, 0), b3, voffB); PG8_STAGE(PG8_SB(1, 1), b3 + hstep, voffB); PG8_STAGE(PG8_SA(1, 0), a3, voffA);
            PG8_WAIT_V(8); PG8_WAIT_L(0); PG8_BAR; PG8_MMA(1, 0, At, B0); PG8_MMA(1, 1, At, B1); PG8_BAR; PG8_SCHED;
            } else {
            PG8_LDB(B0, 0, 0); PG8_SCHED; PG8_LDA(At, 0, 0); PG8_STAGE(PG8_SA(1, 1), a1 + hstep, voffA);
            PG8_WAIT_L(8); PG8_BAR; PG8_WAIT_L(0); PG8_MMA(0, 0, At, B0); PG8_BAR; PG8_SCHED;
            PG8_LDB(B1, 0, 1); PG8_STAGE(PG8_SB(0, 0), b2, voffB);
            PG8_BAR; PG8_WAIT_L(0); PG8_MMA(0, 1, At, B1); PG8_BAR;
            PG8_LDA(At, 0, 1); PG8_STAGE(PG8_SA(0, 0), a2, voffA);
            PG8_BAR; PG8_WAIT_L(0); PG8_MMA(1, 0, At, B0); PG8_BAR; PG8_SCHED;
            PG8_STAGE(PG8_SB(0, 1), b2 + hstep, voffB);
            PG8_WAIT_V(6); PG8_BAR; PG8_MMA(1, 1, At, B1); PG8_BAR;
            PG8_LDB(B0, 1, 0); PG8_SCHED; PG8_LDA(At, 1, 0); PG8_STAGE(PG8_SA(0, 1), a2 + hstep, voffA);
            PG8_WAIT_L(8); PG8_BAR; PG8_WAIT_L(0); PG8_MMA(0, 0, At, B0); PG8_BAR; PG8_SCHED;
            PG8_LDB(B1, 1, 1); PG8_STAGE(PG8_SB(1, 0), b3, voffB);
            PG8_BAR; PG8_WAIT_L(0); PG8_MMA(0, 1, At, B1); PG8_BAR;
            PG8_LDA(At, 1, 1); PG8_STAGE(PG8_SA(1, 0), a3, voffA);
            PG8_BAR; PG8_WAIT_L(0); PG8_MMA(1, 0, At, B0); PG8_BAR; PG8_SCHED;
            PG8_STAGE(PG8_SB(1, 1), b3 + hstep, voffB);
            PG8_WAIT_V(6); PG8_BAR; PG8_MMA(1, 1, At, B1); PG8_BAR;
            }
        }
        if constexpr (ALIGN_EPI) { if (wr == 0) PG8_BAR; }
        if constexpr (!Epi::AFTER_DRAIN) { E(acc, cur, wr, wc, fr, fq); S.done(cur); }
        if (!has_next) break;
#pragma unroll
        for (int a = 0; a < 2; ++a)
#pragma unroll
            for (int b = 0; b < 2; ++b)
#pragma unroll
                for (int m = 0; m < 4; ++m)
#pragma unroll
                    for (int n = 0; n < 2; ++n) acc[a][b][m][n] = (f32x4){0.f, 0.f, 0.f, 0.f};
        cur = nxt; cA = nA; cB = nB; ++ui;
        if constexpr (ALIGN_EPI) { if (wr == 1) PG8_BAR; }
    }
    PG8_WAIT_V(0);
    if constexpr (!ALIGN_EPI) { if (wr == 0) PG8_BAR; }
    PG8_BAR;
    if constexpr (Epi::AFTER_DRAIN) { E.fused(acc, cur, wr, wc, fr, fq, lds, wid, lane); S.done(cur); }
#undef PG8_SA
#undef PG8_SB
#undef PG8_STAGE
#undef PG8_LDA
#undef PG8_LDB
#undef PG8_MMA
#undef PG8_WAIT_V
#undef PG8_WAIT_L
#undef PG8_BAR
#undef PG8_SCHED
}
}
#define GAS __attribute__((address_space(1)))
#define LAS __attribute__((address_space(3)))
typedef unsigned short bf16;
typedef unsigned v4u __attribute__((ext_vector_type(4)));
typedef float f32x4 __attribute__((ext_vector_type(4)));
typedef short bf16x8 __attribute__((ext_vector_type(8)));
typedef GAS unsigned gu32;
typedef GAS unsigned long long gu64;
#define RLX_AGENT __ATOMIC_RELAXED, __HIP_MEMORY_SCOPE_AGENT
#define LDS_WAIT() asm volatile("s_waitcnt lgkmcnt(0)" ::: "memory")
#define VM_WAIT() asm volatile("s_waitcnt vmcnt(0)" ::: "memory")
__device__ __forceinline__ unsigned long long rt() { return __builtin_amdgcn_s_memrealtime(); }
__device__ __forceinline__ unsigned f2bf(float f) { unsigned u = __builtin_bit_cast(unsigned, f); return (u + 0x7fffu + ((u >> 16) & 1u)) >> 16; }
__device__ __forceinline__ unsigned pk2(float lo, float hi) { return f2bf(lo) | (f2bf(hi) << 16); }

#define XB_TMO      128
#define XB_XCNT(j)  (256  + 64 * (j))
#define XB_XSUB(j)  (1280 + 64 * (j))
#define XB_XGEN(j)  (2304 + 64 * (j))
#define XB_TOP      3328
#define XB_TOPGEN   3392
#define XCD_BAR_WORDS 3456
#define XB_SPIN_CAP (1u << 24)

__device__ __forceinline__ unsigned xb_ld(unsigned* p)              { return __hip_atomic_load(p, __ATOMIC_RELAXED, __HIP_MEMORY_SCOPE_AGENT); }
__device__ __forceinline__ unsigned xb_add(unsigned* p, unsigned v) { return __hip_atomic_fetch_add(p, v, __ATOMIC_RELAXED, __HIP_MEMORY_SCOPE_AGENT); }
__device__ __forceinline__ unsigned xb_xcc_id() { return (unsigned)__builtin_amdgcn_s_getreg((3 << 11) | 20) & 0xFu; }
#define XB_SPIN(cond, bar) do { unsigned _sp = 0; while (cond) { __builtin_amdgcn_s_sleep(1); \
    if ((++_sp & 255u) == 0u) { if (xb_ld(&(bar)[XB_TMO])) break; if (_sp > XB_SPIN_CAP) { atomicAdd(&(bar)[XB_TMO], 1u); break; } } } } while (0)

struct XcdBarrier {
    unsigned* bar; unsigned x;
    volatile LAS unsigned* st;
};

__device__ __forceinline__ XcdBarrier xcd_barrier_post(unsigned* bar, volatile LAS unsigned* st) {
    XcdBarrier b; b.bar = bar; b.x = xb_xcc_id(); b.st = st;
    if (threadIdx.x == 0) (void)xb_add(&bar[XB_XCNT(b.x)], 1u);
    return b;
}
__device__ __forceinline__ void xcd_barrier_complete(unsigned* bar, unsigned x, unsigned& nloc, unsigned& nx) {
    const unsigned G = gridDim.x * gridDim.y * gridDim.z;
    unsigned sum, cnt, mine, sp = 0u;
    for (;;) {
        sum = 0u; cnt = 0u; mine = 0u;
#pragma unroll
        for (unsigned j = 0; j < 16; ++j) { const unsigned c = xb_ld(&bar[XB_XCNT(j)]); sum += c; cnt += (c > 0u) ? 1u : 0u; mine = (j == x) ? c : mine; }
        if (sum == G) break;
        __builtin_amdgcn_s_sleep(1);
        if ((++sp & 255u) == 0u) { if (xb_ld(&bar[XB_TMO])) break; if (sp > XB_SPIN_CAP) { atomicAdd(&bar[XB_TMO], 1u); break; } }
    }
    nloc = mine > 0u ? mine : 1u; nx = cnt > 0u ? cnt : 1u;
}

__device__ __forceinline__ void xcd_barrier(const XcdBarrier& b) {
    asm volatile("s_waitcnt vmcnt(0)" ::: "memory");
    __syncthreads();
    if (threadIdx.x == 0) {
        unsigned* bar = b.bar;
        __builtin_amdgcn_s_waitcnt(0);
        unsigned nloc = b.st[0], nx = b.st[1];
        if (nloc == 0u) { xcd_barrier_complete(bar, b.x, nloc, nx); b.st[0] = nloc; b.st[1] = nx; }
        const unsigned old = xb_add(&bar[XB_XSUB(b.x)], 1u);
        const unsigned gen = old / nloc;
        if (old + 1u == (gen + 1u) * nloc) {
            __builtin_amdgcn_fence(__ATOMIC_RELEASE, "agent");
            asm volatile("s_waitcnt vmcnt(0)" ::: "memory");
            const unsigned og = xb_add(&bar[XB_TOP], 1u);
            const unsigned tg = og / nx;
            if (og + 1u == (tg + 1u) * nx) xb_add(&bar[XB_TOPGEN], 1u);
            else XB_SPIN(xb_ld(&bar[XB_TOPGEN]) == tg, bar);
            __builtin_amdgcn_fence(__ATOMIC_ACQUIRE, "agent");
            xb_add(&bar[XB_XGEN(b.x)], 1u);
            asm volatile("s_waitcnt vmcnt(0)" ::: "memory");
        } else {
            XB_SPIN(xb_ld(&bar[XB_XGEN(b.x)]) == gen, bar);
            __builtin_amdgcn_fence(__ATOMIC_ACQUIRE, "agent");
            asm volatile("s_waitcnt vmcnt(0)" ::: "memory");
        }
    }
    __syncthreads();
}

constexpr int NWAVES = 8;
constexpr int BATCH = 4, SEQ = 8192, D = 1024, M = BATCH * SEQ;
constexpr int NIN = 7184, NPROJ = 7168;
constexpr int P5W = 5120, YGW = 2048;
constexpr int P5_SBQ = 0, P5_SBK = 1024, P5_SBV = 2048, P5_GQ = 3072, P5_GK = 3584, P5_GV = 4096;
constexpr int SBH = 8, SBD = 128, GH = 4, GDK = 128, GDV = 256, RANK = 16;
constexpr float NORM_EPS = 1e-6f;

constexpr size_t MiB = 1u << 20;
constexpr size_t WS_CTL = 0, CTL_ZERO_BYTES = 1 * MiB;
constexpr size_t WS_WIN = 2 * MiB;
constexpr size_t WS_WOUT = 16 * MiB;
constexpr size_t WS_RS = 20 * MiB;
constexpr size_t WS_LR = 21 * MiB;
constexpr size_t WS_P5 = 24 * MiB;
constexpr size_t WS_YG = 344 * MiB;
constexpr size_t WS_END = 472 * MiB;
constexpr int CW_BAR = 4096;

constexpr int RING_OFF = 0, RING_BYTES = 131072;
constexpr int LDSCTL_OFF = RING_BYTES, MISC_OFF = LDSCTL_OFF + 320;
constexpr int LDS_BYTES = 147456;

struct Frame {
    LAS unsigned char* lds;
    volatile LAS unsigned* MISC;
    gu32* ctl;
    int tid, lane, wave;
    int vcu, G;
};

__device__ __forceinline__ float wave_sum(float v) {
#pragma unroll
    for (int o = 1; o < 64; o <<= 1) v += __shfl_xor(v, o);
    return v;
}
__device__ __forceinline__ float bf2f(unsigned short b) { return __uint_as_float(((unsigned)b) << 16); }

__device__ __forceinline__ void p0_transpose_item(const float* W, int ldw, int n_src0, const float* kscale, bf16* WT, int K, int n_dst0, int k0, LAS float* scr, int lane) {
    float tv[32];
#pragma unroll
    for (int i = 0; i < 32; ++i) { const int kk = 2 * i + (lane >> 5); tv[i] = W[(size_t)(k0 + kk) * ldw + n_src0 + (lane & 31)]; }
#pragma unroll
    for (int i = 0; i < 32; ++i) { const int kk = 2 * i + (lane >> 5); float v = tv[i]; if (kscale) v *= kscale[k0 + kk]; scr[kk * 33 + (lane & 31)] = v; }
    LDS_WAIT(); asm volatile("" ::: "memory");
    const int c = lane & 7;
#pragma unroll
    for (int j = 0; j < 4; ++j) { const int n = (lane >> 3) + 8 * j; const LAS float* s = scr + (8 * c) * 33 + n;
        v4u o; o.x = pk2(s[0 * 33], s[1 * 33]); o.y = pk2(s[2 * 33], s[3 * 33]); o.z = pk2(s[4 * 33], s[5 * 33]); o.w = pk2(s[6 * 33], s[7 * 33]);
        *(GAS v4u*)(WT + (size_t)(n_dst0 + n) * K + k0 + 8 * c) = o; }
    LDS_WAIT(); asm volatile("" ::: "memory");
}
__device__ __forceinline__ int win_src_col(int n) { return n < 3072 ? n : (n < 5120 ? n + 1024 : (n < 6144 ? n - 2048 : n)); }

struct Args { const float* in[9]; float* out; unsigned char* ws; int ph_lo, ph_hi, li, pad; };

__device__ __forceinline__ void p0_prologue(Frame& F, const Args& a) {
    const float* x = a.in[0]; const float* pre_w = a.in[1]; const float* w_in = a.in[2]; const float* w_out = a.in[7];
    bf16* WinT = (bf16*)(a.ws + WS_WIN); bf16* WoutT = (bf16*)(a.ws + WS_WOUT);
    float* RS = (float*)(a.ws + WS_RS); float* LR = (float*)(a.ws + WS_LR);
    bf16* XB = (bf16*)a.out;
    const int gw = F.vcu * NWAVES + F.wave, NGW = F.G * NWAVES;
    {
        LAS float* scr = (LAS float*)(F.lds + RING_OFF + F.wave * 16384);
        constexpr int I_IN = (D / 64) * (NPROJ / 32), I_OUT = (2048 / 64) * (D / 32);
        for (int it = gw; it < I_IN + I_OUT; it += NGW) {
            if (it < I_IN) { const int nb = it % (NPROJ / 32), kb = it / (NPROJ / 32); p0_transpose_item(w_in, NIN, win_src_col(32 * nb), pre_w, WinT, D, 32 * nb, 64 * kb, scr, F.lane); }
            else { const int r = it - I_IN, nb = r % (D / 32), kb = r / (D / 32); p0_transpose_item(w_out, D, 32 * nb, nullptr, WoutT, 2048, 32 * nb, 64 * kb, scr, F.lane); }
        }
    }
    __syncthreads();
    LAS float* WL = (LAS float*)(F.lds + RING_OFF);
    for (int k = F.tid; k < D; k += NWAVES * 64) {
        const float g = pre_w[k]; const f32x4* src = (const f32x4*)(w_in + (size_t)k * NIN + NPROJ);
#pragma unroll
        for (int q = 0; q < 4; ++q) { const f32x4 w = src[q]; WL[(4 * q + 0) * D + k] = w.x * g; WL[(4 * q + 1) * D + k] = w.y * g; WL[(4 * q + 2) * D + k] = w.z * g; WL[(4 * q + 3) * D + k] = w.w * g; }
    }
    __syncthreads();
    f32x4 nv[4];
    if (gw < M) { const GAS f32x4* xr = (const GAS f32x4*)(x + (size_t)gw * D) + F.lane;
#pragma unroll
        for (int j = 0; j < 4; ++j) nv[j] = xr[64 * j]; }
    for (int m = gw; m < M; m += NGW) {
        f32x4 v[4]; float s = 0.f;
#pragma unroll
        for (int j = 0; j < 4; ++j) v[j] = nv[j];
        if (m + NGW < M) { const GAS f32x4* xr = (const GAS f32x4*)(x + (size_t)(m + NGW) * D) + F.lane;
#pragma unroll
            for (int j = 0; j < 4; ++j) nv[j] = xr[64 * j]; }
#pragma unroll
        for (int j = 0; j < 4; ++j) s += (v[j].x * v[j].x + v[j].y * v[j].y) + (v[j].z * v[j].z + v[j].w * v[j].w);
        const float rstd = 1.0f / sqrtf(wave_sum(s) * (1.f / D) + NORM_EPS);
        GAS unsigned long long* o8 = (GAS unsigned long long*)(XB + (size_t)m * D) + F.lane;
#pragma unroll
        for (int j = 0; j < 4; ++j) o8[64 * j] = (unsigned long long)pk2(v[j].x, v[j].y) | ((unsigned long long)pk2(v[j].z, v[j].w) << 32);
        float p[16];
#pragma unroll
        for (int n = 0; n < 16; ++n) { float acc = 0.f;
#pragma unroll
            for (int j = 0; j < 4; ++j) { const f32x4 w = *(const LAS f32x4*)(WL + n * D + 4 * F.lane + 256 * j); acc += (v[j].x * w.x + v[j].y * w.y) + (v[j].z * w.z + v[j].w * w.w); }
            p[n] = acc; if (n & 1) asm volatile("" ::: "memory"); }
        float q8[8], q4[4], q2[2], q1;
        { const bool hi = (F.lane & 32) != 0;
#pragma unroll
          for (int i = 0; i < 8; ++i) { const float keep = hi ? p[i + 8] : p[i], send = hi ? p[i] : p[i + 8]; q8[i] = keep + __shfl_xor(send, 32); } }
        { const bool hi = (F.lane & 16) != 0;
#pragma unroll
          for (int i = 0; i < 4; ++i) { const float keep = hi ? q8[i + 4] : q8[i], send = hi ? q8[i] : q8[i + 4]; q4[i] = keep + __shfl_xor(send, 16); } }
        { const bool hi = (F.lane & 8) != 0;
#pragma unroll
          for (int i = 0; i < 2; ++i) { const float keep = hi ? q4[i + 2] : q4[i], send = hi ? q4[i] : q4[i + 2]; q2[i] = keep + __shfl_xor(send, 8); } }
        { const bool hi = (F.lane & 4) != 0; const float keep = hi ? q2[1] : q2[0], send = hi ? q2[0] : q2[1]; q1 = keep + __shfl_xor(send, 4); }
        q1 += __shfl_xor(q1, 2); q1 += __shfl_xor(q1, 1);
        if ((F.lane & 3) == 0) { const int n = ((F.lane >> 5) & 1) * 8 + ((F.lane >> 4) & 1) * 4 + ((F.lane >> 3) & 1) * 2 + ((F.lane >> 2) & 1); LR[(size_t)m * RANK + n] = q1 * rstd; }
        if (F.lane == 0) RS[m] = rstd;
    }
}

__device__ __forceinline__ void p4_final(Frame& F, const Args& a) {
    const float* x = a.in[0]; const float* post_w = a.in[8]; float* out = a.out;
    const int gw = F.vcu * NWAVES + F.wave, NGW = F.G * NWAVES;
    f32x4 g[4];
#pragma unroll
    for (int j = 0; j < 4; ++j) g[j] = *((const f32x4*)post_w + F.lane + 64 * j);
    for (int m = gw; m < M; m += NGW) {
        GAS f32x4* yr = (GAS f32x4*)(out + (size_t)m * D) + F.lane; const GAS f32x4* xr = (const GAS f32x4*)(x + (size_t)m * D) + F.lane;
        f32x4 v[4], xv[4]; float s = 0.f;
#pragma unroll
        for (int j = 0; j < 4; ++j) { v[j] = yr[64 * j]; xv[j] = xr[64 * j]; s += (v[j].x * v[j].x + v[j].y * v[j].y) + (v[j].z * v[j].z + v[j].w * v[j].w); }
        const float rstd = 1.0f / sqrtf(wave_sum(s) * (1.f / D) + NORM_EPS);
#pragma unroll
        for (int j = 0; j < 4; ++j) yr[64 * j] = xv[j] + (v[j] * rstd) * g[j];
    }
}

typedef float f32x16 __attribute__((ext_vector_type(16)));
typedef short s16x4 __attribute__((ext_vector_type(4)));
typedef float f32x2_t __attribute__((ext_vector_type(2)));
typedef __bf16 bf16x2_t __attribute__((ext_vector_type(2)));
#define MFMA32(a, b, c) __builtin_amdgcn_mfma_f32_32x32x16_bf16((a), (b), (c), 0, 0, 0)
__device__ __forceinline__ unsigned cvtpk(float lo, float hi) { f32x2_t v = {lo, hi}; bf16x2_t b = __builtin_convertvector(v, bf16x2_t); return __builtin_bit_cast(unsigned, b); }
__device__ __forceinline__ unsigned off_a(unsigned row, unsigned ch) { return 2048u * (row >> 3) + 512u * (ch >> 2) + 64u * (row & 7) + 16u * ((ch & 3) ^ ((row >> 2) & 3)); }
__device__ __forceinline__ s16x4 tr_read(LAS unsigned char* p) { return __builtin_amdgcn_ds_read_tr16_b64_v4i16((LAS s16x4*)p); }
__device__ __forceinline__ bf16x8 cat8(s16x4 lo, s16x4 hi) { return __builtin_shufflevector(lo, hi, 0, 1, 2, 3, 4, 5, 6, 7); }
constexpr float LOG2E = 1.4426950408889634f;

constexpr float SB_DONE = -160.f;
__device__ __forceinline__ int sb_kap(int r) { return 16 * ((r >> 2) & 1) + 4 * (r >> 3) + (r & 3); }

__device__ __forceinline__ void sb_weights(f32x16& C, int lim, int h, float& carry, bf16x8 (&ps)[2]) {
    float aft[16]; float run = 0.f;
#pragma unroll
    for (int i = 15; i >= 0; --i) {
        const float z = C[i];
        const float sp = fmaxf(z, 0.f) + __builtin_amdgcn_logf(1.0f + __builtin_amdgcn_exp2f(-fabsf(z)));
        const bool valid = (16 * h + i) < lim;
        const float lf = valid ? -sp : 0.f;
        C[i] = valid ? (z - sp) : -1000.f;
        aft[i] = run; run += lf;
    }
    const float other = __shfl_xor(run, 32);
    const float base = carry + (h == 0 ? other : 0.f);
    carry += run + other;
    unsigned pw[8];
#pragma unroll
    for (int i = 0; i < 8; ++i) pw[i] = cvtpk(__builtin_amdgcn_exp2f(C[2 * i] + aft[2 * i] + base), __builtin_amdgcn_exp2f(C[2 * i + 1] + aft[2 * i + 1] + base));
    const v4u a = {pw[0], pw[1], pw[2], pw[3]}, bb = {pw[4], pw[5], pw[6], pw[7]}; ps[0] = __builtin_bit_cast(bf16x8, a); ps[1] = __builtin_bit_cast(bf16x8, bb);
}
__device__ __forceinline__ void sb_pv(f32x16 (&O)[4], const bf16x8 (&ps)[2], LAS unsigned char* vimg, int lane) {
    const unsigned h = lane >> 5, blk = (lane >> 4) & 1, q4 = (lane & 15) >> 2, p4 = lane & 3, bo = 8 * (p4 & 1);
#pragma unroll
    for (int c = 0; c < 4; ++c)
#pragma unroll
        for (int ks = 0; ks < 2; ++ks) {
            const unsigned ch = 4 * c + 2 * blk + (p4 >> 1);
            const s16x4 lo = tr_read(vimg + off_a(16 * h + 8 * ks + q4, ch) + bo);
            const s16x4 hi = tr_read(vimg + off_a(16 * h + 8 * ks + 4 + q4, ch) + bo);
            O[c] = MFMA32(cat8(lo, hi), ps[ks], O[c]);
        }
}
__device__ __forceinline__ void sb_epilogue(const f32x16 (&O)[4], size_t rowq, int hd, int h, bf16* YG, const float* __restrict__ sb_norm_w) {
    float ss = 0.f;
#pragma unroll
    for (int c = 0; c < 4; ++c)
#pragma unroll
        for (int i = 0; i < 16; ++i) ss += O[c][i] * O[c][i];
    ss += __shfl_xor(ss, 32);
    const float rstd = __builtin_amdgcn_rsqf(ss * (1.f / SBD) + NORM_EPS);
    bf16* yrow = YG + rowq * YGW + hd * SBD + 4 * h;
    const float* nwp = sb_norm_w + hd * SBD + 4 * h;
#pragma unroll
    for (int c = 0; c < 4; ++c)
#pragma unroll
        for (int g = 0; g < 4; ++g) {
            const int d0 = 32 * c + 8 * g;
            const uint2 gg = *(const uint2*)(yrow + d0); const f32x4 nw = *(const f32x4*)(nwp + d0);
            const float g0 = bf2f(gg.x & 0xffff), g1 = bf2f(gg.x >> 16), g2 = bf2f(gg.y & 0xffff), g3 = bf2f(gg.y >> 16);
            const float y0 = O[c][4 * g + 0] * rstd * nw.x * (g0 * __builtin_amdgcn_rcpf(1.0f + __builtin_amdgcn_exp2f(-g0 * LOG2E)));
            const float y1 = O[c][4 * g + 1] * rstd * nw.y * (g1 * __builtin_amdgcn_rcpf(1.0f + __builtin_amdgcn_exp2f(-g1 * LOG2E)));
            const float y2 = O[c][4 * g + 2] * rstd * nw.z * (g2 * __builtin_amdgcn_rcpf(1.0f + __builtin_amdgcn_exp2f(-g2 * LOG2E)));
            const float y3 = O[c][4 * g + 3] * rstd * nw.w * (g3 * __builtin_amdgcn_rcpf(1.0f + __builtin_amdgcn_exp2f(-g3 * LOG2E)));
            uint2 o; o.x = cvtpk(y0, y1); o.y = cvtpk(y2, y3);
            *(uint2*)(yrow + d0) = o;
        }
}

__device__ __forceinline__ void sb_epi_issue(uint2 (&gq)[16], size_t rowq, int hd, int h, const bf16* YG) {
    const bf16* yrow = YG + rowq * YGW + hd * SBD + 4 * h;
#pragma unroll
    for (int c = 0; c < 4; ++c)
#pragma unroll
        for (int g = 0; g < 4; ++g) gq[4 * c + g] = *(const uint2*)(yrow + 32 * c + 8 * g);
}
__device__ __forceinline__ void sb_epi_finish(const f32x16 (&O)[4], const uint2 (&gq)[16], size_t rowq, int hd, int h, bf16* YG, const LAS float* nwl) {
    float ss = 0.f;
#pragma unroll
    for (int c = 0; c < 4; ++c)
#pragma unroll
        for (int i = 0; i < 16; ++i) ss += O[c][i] * O[c][i];
    ss += __shfl_xor(ss, 32);
    const float rstd = __builtin_amdgcn_rsqf(ss * (1.f / SBD) + NORM_EPS);
    bf16* yrow = YG + rowq * YGW + hd * SBD + 4 * h;
#pragma unroll
    for (int c = 0; c < 4; ++c)
#pragma unroll
        for (int g = 0; g < 4; ++g) {
            const int d0 = 32 * c + 8 * g;
            const uint2 gg = gq[4 * c + g]; const f32x4 nw = *(const LAS f32x4*)(nwl + d0 + 4 * h);
            const float g0 = bf2f(gg.x & 0xffff), g1 = bf2f(gg.x >> 16), g2 = bf2f(gg.y & 0xffff), g3 = bf2f(gg.y >> 16);
            const float y0 = O[c][4 * g + 0] * rstd * nw.x * (g0 * __builtin_amdgcn_rcpf(1.0f + __builtin_amdgcn_exp2f(-g0 * LOG2E)));
            const float y1 = O[c][4 * g + 1] * rstd * nw.y * (g1 * __builtin_amdgcn_rcpf(1.0f + __builtin_amdgcn_exp2f(-g1 * LOG2E)));
            const float y2 = O[c][4 * g + 2] * rstd * nw.z * (g2 * __builtin_amdgcn_rcpf(1.0f + __builtin_amdgcn_exp2f(-g2 * LOG2E)));
            const float y3 = O[c][4 * g + 3] * rstd * nw.w * (g3 * __builtin_amdgcn_rcpf(1.0f + __builtin_amdgcn_exp2f(-g3 * LOG2E)));
            uint2 o; o.x = cvtpk(y0, y1); o.y = cvtpk(y2, y3);
            *(uint2*)(yrow + d0) = o;
        }
}

__device__ __forceinline__ void sb_item_indep(int b, int hd, int qb, LAS unsigned char* vimg, int lane, const bf16* __restrict__ P5, bf16* YG, const float* __restrict__ sb_norm_w) {
    const int r = lane & 31, h = lane >> 5, kap = sb_kap(r);
    const size_t rowq = (size_t)b * SEQ + 32 * qb + r;
    bf16x8 qf[8];
    { const bf16* qp = P5 + rowq * P5W + P5_SBQ + hd * SBD + 8 * h;
#pragma unroll
      for (int s = 0; s < 8; ++s) qf[s] = *(const bf16x8*)(qp + 16 * s); }
    f32x16 O[4];
#pragma unroll
    for (int c = 0; c < 4; ++c)
#pragma unroll
        for (int i = 0; i < 16; ++i) O[c][i] = 0.f;
    float carry = 0.f;
    for (int kt = qb; kt >= 0; --kt) {
        const size_t rowk0 = (size_t)b * SEQ + 32 * kt;
        bf16x8 kf[8];
        { const bf16* kp = P5 + (rowk0 + kap) * P5W + P5_SBK + hd * SBD + 8 * h;
#pragma unroll
          for (int s = 0; s < 8; ++s) kf[s] = *(const bf16x8*)(kp + 16 * s); }
#pragma unroll
        for (int i = 0; i < 8; ++i) { const int n = lane + 64 * i, row = n >> 4, ch = n & 15;
            const v4u v = *(const v4u*)(P5 + (rowk0 + row) * P5W + P5_SBV + hd * SBD + 8 * ch);
            *(LAS v4u*)(vimg + off_a(row, ch)) = v; }
        f32x16 C;
#pragma unroll
        for (int i = 0; i < 16; ++i) C[i] = 0.f;
#pragma unroll
        for (int s = 0; s < 8; ++s) C = MFMA32(kf[s], qf[s], C);
        bf16x8 ps[2];
        sb_weights(C, (kt == qb) ? r : 64, h, carry, ps);
        sb_pv(O, ps, vimg, lane);
        if (__all(carry < SB_DONE)) break;
    }
    sb_epilogue(O, rowq, hd, h, YG, sb_norm_w);
}

constexpr int SBS_SLOT = 16384, SBS_FLAGS = 32768, SBS_PRIV = 65536;
__device__ __forceinline__ void sb_phase(Frame& F, const bf16* __restrict__ P5, bf16* YG, const float* __restrict__ sb_norm_w) {
    LAS unsigned char* L = F.lds + RING_OFF;
    volatile LAS unsigned* flags = (volatile LAS unsigned*)(L + SBS_FLAGS);
    LAS float* nwl = (LAS float*)(L + SBS_FLAGS + 1024);
    const int w = F.wave;
    for (int task = F.vcu; task < 256; task += F.G) {
        const int rg = task & 7, hd = (task >> 3) & 7, b = task >> 6, R0 = 32 * rg, Ttop = R0 + 31;
        int tid = F.tid; asm volatile("" : "+v"(tid));
        const int lane = tid & 63, r = lane & 31, h = lane >> 5;
        const int srow = tid >> 4, sch = tid & 15;
        const bf16* kbase = P5 + ((size_t)b * SEQ + sb_kap(srow)) * P5W + P5_SBK + hd * SBD + 8 * sch;
        const bf16* vbase = P5 + ((size_t)b * SEQ + srow) * P5W + P5_SBV + hd * SBD + 8 * sch;
        const unsigned soff = off_a(srow, sch);
        __syncthreads();
        if (tid < 64) flags[tid] = 0u;
        if (tid >= 128 && tid < 256) nwl[tid - 128] = sb_norm_w[hd * SBD + tid - 128];
        { const v4u k0 = *(const v4u*)(kbase + (size_t)(32 * Ttop) * P5W), v0 = *(const v4u*)(vbase + (size_t)(32 * Ttop) * P5W);
          *(LAS v4u*)(L + (Ttop & 1) * SBS_SLOT + soff) = k0; *(LAS v4u*)(L + (Ttop & 1) * SBS_SLOT + 8192 + soff) = v0; }
        v4u stk = {0u, 0u, 0u, 0u}, stv = {0u, 0u, 0u, 0u};
        if (Ttop >= 1) { stk = *(const v4u*)(kbase + (size_t)(32 * (Ttop - 1)) * P5W); stv = *(const v4u*)(vbase + (size_t)(32 * (Ttop - 1)) * P5W); }
        int cur = -1, nextq = R0 + 24 + w;
        bf16x8 qf[8];
        { const bf16* qp = P5 + ((size_t)b * SEQ + 32 * nextq + r) * P5W + P5_SBQ + hd * SBD + 8 * h;
#pragma unroll
          for (int s = 0; s < 8; ++s) qf[s] = *(const bf16x8*)(qp + 16 * s); }
        f32x16 O[4];
#pragma unroll
        for (int c = 0; c < 4; ++c)
#pragma unroll
            for (int i = 0; i < 16; ++i) O[c][i] = 0.f;
        float carry = 0.f;
        uint2 gq[16];
#pragma unroll
        for (int i = 0; i < 16; ++i) gq[i] = make_uint2(0u, 0u);
        for (int T = Ttop; T >= 0; --T) {
            __syncthreads();
            if (T < R0) {
                unsigned any = 0u;
#pragma unroll
                for (int i = 0; i < 8; ++i) any |= flags[((T + 1) & 1) * 8 + i];
                if (any == 0u) break;
            }
            if (T >= 1) { *(LAS v4u*)(L + ((T - 1) & 1) * SBS_SLOT + soff) = stk; *(LAS v4u*)(L + ((T - 1) & 1) * SBS_SLOT + 8192 + soff) = stv; }
            bool starting = false;
            if (T == nextq && T >= R0) {
                if (cur < 0) { cur = T; carry = 0.f; starting = true;
#pragma unroll
                    for (int c = 0; c < 4; ++c)
#pragma unroll
                        for (int i = 0; i < 16; ++i) O[c][i] = 0.f;
                } else if (lane == 0) { const unsigned slot = __hip_atomic_fetch_add((LAS unsigned*)(L + SBS_FLAGS) + 16, 1u, __ATOMIC_RELAXED, __HIP_MEMORY_SCOPE_WORKGROUP); flags[32 + slot] = (unsigned)T; }
                nextq = T - 8;
            }
            if (cur >= 0) {
                LAS unsigned char* kimg = L + (T & 1) * SBS_SLOT;
                f32x16 C;
#pragma unroll
                for (int i = 0; i < 16; ++i) C[i] = 0.f;
#pragma unroll
                for (int s = 0; s < 8; ++s) { const bf16x8 kf = *(const LAS bf16x8*)(kimg + off_a(r, 2 * s + h)); C = MFMA32(kf, qf[s], C); }
                asm volatile("" : "+v"(C) :: "memory");
                if (T >= 2) { stk = *(const v4u*)(kbase + (size_t)(32 * (T - 2)) * P5W); stv = *(const v4u*)(vbase + (size_t)(32 * (T - 2)) * P5W); }
                if (starting) sb_epi_issue(gq, (size_t)b * SEQ + 32 * cur + r, hd, h, YG);
                bf16x8 ps[2];
                sb_weights(C, (T == cur) ? r : 64, h, carry, ps);
                sb_pv(O, ps, kimg + 8192, lane);
                if (T == 0 || __all(carry < SB_DONE)) {
                    sb_epi_finish(O, gq, (size_t)b * SEQ + 32 * cur + r, hd, h, YG, nwl);
                    cur = -1;
                    if (nextq >= R0) {
                        const bf16* qp = P5 + ((size_t)b * SEQ + 32 * nextq + r) * P5W + P5_SBQ + hd * SBD + 8 * h;
#pragma unroll
                        for (int s = 0; s < 8; ++s) qf[s] = *(const bf16x8*)(qp + 16 * s);
                    }
                }
            } else if (T >= 2) { stk = *(const v4u*)(kbase + (size_t)(32 * (T - 2)) * P5W); stv = *(const v4u*)(vbase + (size_t)(32 * (T - 2)) * P5W); }
            if (lane == 0) flags[(T & 1) * 8 + w] = (cur >= 0) ? 1u : 0u;
        }
        __syncthreads();
        const unsigned ndef = flags[16];
        for (unsigned i = (unsigned)w; i < ndef; i += NWAVES) sb_item_indep(b, hd, (int)flags[32 + i], L + SBS_PRIV + w * 8192, lane, P5, YG, sb_norm_w);
    }
}

constexpr int GL_QI = 0, GL_KI = 16384, GL_KH = 32768, GL_PI = 49152, GL_PSTRIDE = 144, GL_OS = 0, GL_OSP = 260;
constexpr int GL_VI = 58368, GL_BM = 91136, GL_LRS = 123904, GL_QT = 128000, GL_DV = 130048;
static_assert(GL_DV + 512 <= RING_BYTES, "GLA LDS map");
constexpr size_t GLA_LST_OFF = 0, GLA_DT_OFF = 64 * MiB;

typedef unsigned u32x2v __attribute__((ext_vector_type(2)));
__device__ __forceinline__ unsigned short f2bf16(float f) { return (unsigned short)f2bf(f); }
__device__ __forceinline__ unsigned img64(int row, int col) { return (unsigned)(row >> 5) * 8192u + off_a((unsigned)(row & 31), (unsigned)(col >> 3)) + (unsigned)(col & 7) * 2u; }

constexpr size_t WS_QK0 = 23 * MiB;
__device__ __forceinline__ void gla_t0_exact(Frame& F, const Args& a) {
    const float* x = a.in[0]; const float* pre_w = a.in[1]; const float* w_in = a.in[2]; const float* RS = (const float*)(a.ws + WS_RS);
    float* QK0 = (float*)(a.ws + WS_QK0);
    LAS float* red = (LAS float*)(F.lds + RING_OFF + 65536);
    for (int task = (int)blockIdx.x; task < 256; task += F.G) {
        const int kq = task >> 6, b = (task >> 4) & 3, cg = task & 15;
        const float* xr = x + (size_t)b * SEQ * D; const float* wc = w_in + 4096 + cg * 64 + F.lane;
        const int k0 = 256 * kq + 32 * F.wave;
        float acc = 0.f;
#pragma unroll
        for (int k = 0; k < 32; ++k) acc += (xr[k0 + k] * pre_w[k0 + k]) * wc[(size_t)(k0 + k) * NIN];
        red[F.wave * 64 + F.lane] = acc;
        __syncthreads();
        if (F.wave == 0) { float s = 0.f;
#pragma unroll
            for (int w8 = 0; w8 < 8; ++w8) s += red[w8 * 64 + F.lane];
            QK0[(kq * BATCH + b) * 1024 + cg * 64 + F.lane] = s * RS[(size_t)b * SEQ]; }
        __syncthreads();
    }
}

template <bool OUT>
__device__ __forceinline__ void gla_pass(Frame& F, const Args& a) {
    const bf16* P5 = (const bf16*)(a.ws + WS_P5); bf16* YG = (bf16*)(a.ws + WS_YG); const float* LR = (const float*)(a.ws + WS_LR);
    const float* w_alpha2 = a.in[3]; const float* b_alpha2 = a.in[4]; const float* gnw = a.in[6];
    float* LST = (float*)((char*)a.out + GLA_LST_OFF); float* DT = (float*)((char*)a.out + GLA_DT_OFF);
    LAS unsigned char* L = F.lds + RING_OFF;
    LAS float* LRS = (LAS float*)(L + GL_LRS); LAS float* QT = (LAS float*)(L + GL_QT); LAS float* DV = (LAS float*)(L + GL_DV); LAS float* OS = (LAS float*)(L + GL_OS); LAS float* BM = (LAS float*)(L + GL_BM);
    const int w = F.wave, dvh = w >> 2, cw = w & 3;
    for (int item = (int)blockIdx.x; item < 256; item += F.G) {
        const int bh = item >> 4, sc = item & 15, b = bh >> 2, hd = bh & 3;
        if (!OUT && sc == 15) continue;
        f32x16 S[4];
        const int lane0 = F.lane, r0 = lane0 & 31, h0 = lane0 >> 5;
        float* sbase = LST + ((size_t)(bh * 16 + sc) * GDK) * GDV + 32 * w + r0;
        if (OUT && sc > 0) {
#pragma unroll
            for (int k4 = 0; k4 < 4; ++k4)
#pragma unroll
                for (int i = 0; i < 16; ++i) S[k4][i] = sbase[(size_t)(32 * k4 + (i & 3) + 8 * (i >> 2) + 4 * h0) * GDV];
        } else {
#pragma unroll
            for (int k4 = 0; k4 < 4; ++k4)
#pragma unroll
                for (int i = 0; i < 16; ++i) S[k4][i] = 0.f;
        }
        float sumB[8];
#pragma unroll
        for (int e = 0; e < 8; ++e) sumB[e] = 0.f;
        f32x4 nw = {0.f, 0.f, 0.f, 0.f};
        if (OUT) nw = *(const f32x4*)(gnw + hd * GDV + 4 * lane0);
        for (int c = 0; c < 8; ++c) {
            int tid = F.tid; asm volatile("" : "+v"(tid));
            const int lane = tid & 63, r = lane & 31, h = lane >> 5;
            const unsigned blk = (lane >> 4) & 1, q4 = (lane & 15) >> 2, p4 = lane & 3, bo = 8 * (p4 & 1);
            const int dk = tid & 127, tq = __builtin_amdgcn_readfirstlane(tid >> 7);
            const size_t row0 = (size_t)b * SEQ + sc * 512 + c * 64;
            { const f32x2_t v = *(const f32x2_t*)(LR + row0 * RANK + 2 * tid); *(LAS f32x2_t*)(LRS + 2 * tid) = v; }
            float wa[16];
#pragma unroll
            for (int j = 0; j < 16; ++j) wa[j] = w_alpha2[j * 512 + hd * GDK + dk];
            const float ba = b_alpha2[hd * GDK + dk];
            __syncthreads();
            {
                float run = 0.f;
#pragma unroll
                for (int i = 0; i < 16; ++i) {
                    const LAS f32x4* lp = (const LAS f32x4*)(LRS + (16 * tq + i) * RANK);
                    const f32x4 l0 = lp[0], l1 = lp[1], l2 = lp[2], l3 = lp[3];
                    float lg = ba;
                    lg += l0.x * wa[0] + l0.y * wa[1] + l0.z * wa[2] + l0.w * wa[3];
                    lg += l1.x * wa[4] + l1.y * wa[5] + l1.z * wa[6] + l1.w * wa[7];
                    lg += l2.x * wa[8] + l2.y * wa[9] + l2.z * wa[10] + l2.w * wa[11];
                    lg += l3.x * wa[12] + l3.y * wa[13] + l3.z * wa[14] + l3.w * wa[15];
                    const float x2 = lg * LOG2E;
                    const float ls2 = -(fmaxf(-x2, 0.f) + __builtin_amdgcn_logf(1.0f + __builtin_amdgcn_exp2f(-fabsf(x2))));
                    run += ls2 * (1.0f / 16.0f);
                    BM[(16 * tq + i) * 128 + dk] = run;
                    if ((i & 3) == 3) asm volatile("" ::: "memory");
                }
                QT[tq * 128 + dk] = run;
            }
            __syncthreads();
#pragma unroll
            for (int i2 = 0; i2 < 2; ++i2) {
                const int n = tid + 512 * i2, t = n >> 4, c8 = n & 15, tqq = t >> 4;
                float Bi[8], bl[8];
                { const f32x4 b0 = *(const LAS f32x4*)(BM + t * 128 + 8 * c8), b1 = *(const LAS f32x4*)(BM + t * 128 + 8 * c8 + 4);
                  Bi[0] = b0.x; Bi[1] = b0.y; Bi[2] = b0.z; Bi[3] = b0.w; Bi[4] = b1.x; Bi[5] = b1.y; Bi[6] = b1.z; Bi[7] = b1.w; }
#pragma unroll
                for (int e = 0; e < 8; ++e) bl[e] = 0.f;
#pragma unroll
                for (int q = 0; q < 4; ++q) {
                    const f32x4 t0 = *(const LAS f32x4*)(QT + q * 128 + 8 * c8), t1 = *(const LAS f32x4*)(QT + q * 128 + 8 * c8 + 4);
                    const float tv[8] = {t0.x, t0.y, t0.z, t0.w, t1.x, t1.y, t1.z, t1.w};
#pragma unroll
                    for (int e = 0; e < 8; ++e) { bl[e] += tv[e]; Bi[e] += (q < tqq) ? tv[e] : 0.f; }
                }
                const v4u kraw = *(const v4u*)(P5 + (row0 + t) * P5W + P5_GK + hd * GDK + 8 * c8);
                const unsigned kw[4] = {kraw.x, kraw.y, kraw.z, kraw.w};
                const unsigned ad = (unsigned)(t >> 5) * 8192u + off_a((unsigned)(t & 31), (unsigned)c8);
                v4u o;
                { unsigned ow[4];
#pragma unroll
                  for (int e = 0; e < 4; ++e) ow[e] = cvtpk(bf2f(kw[e] & 0xffff) * __builtin_amdgcn_exp2f(bl[2 * e] - Bi[2 * e]), bf2f(kw[e] >> 16) * __builtin_amdgcn_exp2f(bl[2 * e + 1] - Bi[2 * e + 1]));
                  o.x = ow[0]; o.y = ow[1]; o.z = ow[2]; o.w = ow[3]; *(LAS v4u*)(L + GL_KH + ad) = o; }
                if (OUT) {
                    const v4u qraw = *(const v4u*)(P5 + (row0 + t) * P5W + P5_GQ + hd * GDK + 8 * c8);
                    const unsigned qw[4] = {qraw.x, qraw.y, qraw.z, qraw.w};
                    unsigned ow[4];
#pragma unroll
                    for (int e = 0; e < 4; ++e) ow[e] = cvtpk(bf2f(kw[e] & 0xffff) * __builtin_amdgcn_exp2f(-Bi[2 * e]), bf2f(kw[e] >> 16) * __builtin_amdgcn_exp2f(-Bi[2 * e + 1]));
                    o.x = ow[0]; o.y = ow[1]; o.z = ow[2]; o.w = ow[3]; *(LAS v4u*)(L + GL_KI + ad) = o;
#pragma unroll
                    for (int e = 0; e < 4; ++e) ow[e] = cvtpk(bf2f(qw[e] & 0xffff) * __builtin_amdgcn_exp2f(Bi[2 * e]), bf2f(qw[e] >> 16) * __builtin_amdgcn_exp2f(Bi[2 * e + 1]));
                    o.x = ow[0]; o.y = ow[1]; o.z = ow[2]; o.w = ow[3]; *(LAS v4u*)(L + GL_QI + ad) = o;
                }
                if (i2 == 0 && tid < 16) {
#pragma unroll
                    for (int e = 0; e < 8; ++e) { DV[8 * c8 + e] = __builtin_amdgcn_exp2f(bl[e]); sumB[e] += bl[e]; }
                }
            }
#pragma unroll
            for (int i = 0; i < 4; ++i) { const int n = tid + 512 * i, row = n >> 5, ch32 = n & 31;
                const v4u v = *(const v4u*)(P5 + (row0 + row) * P5W + P5_GV + hd * GDV + 8 * ch32);
                *(LAS v4u*)(L + GL_VI + ((row >> 5) * 2 + (ch32 >> 4)) * 8192 + off_a(row & 31, ch32 & 15)) = v; }
            __syncthreads();
            if (OUT) {
                if (w < 3) {
                    const int tb = (w == 0) ? 0 : 1, sb = (w == 2) ? 1 : 0;
                    f32x16 C;
#pragma unroll
                    for (int i = 0; i < 16; ++i) C[i] = 0.f;
#pragma unroll
                    for (int ks = 0; ks < 8; ++ks) {
                        const bf16x8 af = *(const LAS bf16x8*)(L + GL_KI + sb * 8192 + off_a(r, 2 * ks + h));
                        const bf16x8 bfr = *(const LAS bf16x8*)(L + GL_QI + tb * 8192 + off_a(r, 2 * ks + h));
                        C = MFMA32(af, bfr, C);
                    }
#pragma unroll
                    for (int g = 0; g < 4; ++g) {
                        float v[4];
#pragma unroll
                        for (int e = 0; e < 4; ++e) { const int sl = 8 * g + 4 * h + e; v[e] = (tb != sb || sl <= r) ? C[4 * g + e] : 0.f; }
                        u32x2v o; o.x = cvtpk(v[0], v[1]); o.y = cvtpk(v[2], v[3]);
                        *(LAS u32x2v*)(L + GL_PI + (32 * tb + r) * GL_PSTRIDE + (32 * sb + 8 * g + 4 * h) * 2) = o;
                    }
                    if (w == 0 && sc == 0 && c == 0) {
                        const float* q0 = (const float*)(a.ws + WS_QK0) + b * 1024 + hd * GDK;
                        float qa = 0.f, qb2 = 0.f, ka = 0.f, kb2 = 0.f;
#pragma unroll
                        for (int kq = 0; kq < 4; ++kq) { const float* qq = q0 + kq * BATCH * 1024; qa += qq[lane]; qb2 += qq[lane + 64]; ka += qq[512 + lane]; kb2 += qq[512 + lane + 64]; }
                        const float c00 = wave_sum(qa * ka + qb2 * kb2) * 0.08838834764831845f;
                        if (lane == 0) *(LAS unsigned short*)(L + GL_PI) = (unsigned short)(cvtpk(c00, 0.f) & 0xffffu);
                    }
                }
                __syncthreads();
            }
            {
                bf16x8 vf[4];
#pragma unroll
                for (int ks = 0; ks < 4; ++ks) {
                    LAS unsigned char* vb = L + GL_VI + ((ks >> 1) * 2 + dvh) * 8192; const unsigned ch = 4 * cw + 2 * blk + (p4 >> 1);
                    const s16x4 lo = tr_read(vb + off_a(16 * (ks & 1) + 8 * h + q4, ch) + bo);
                    const s16x4 hi = tr_read(vb + off_a(16 * (ks & 1) + 8 * h + 4 + q4, ch) + bo);
                    vf[ks] = cat8(lo, hi);
                }
                f32x16 oacc[2];
                if (OUT) {
#pragma unroll
                    for (int tb = 0; tb < 2; ++tb)
#pragma unroll
                        for (int i = 0; i < 16; ++i) oacc[tb][i] = 0.f;
#pragma unroll
                    for (int k4 = 0; k4 < 4; ++k4)
#pragma unroll
                        for (int s2 = 0; s2 < 2; ++s2) {
                            v4u pk; pk.x = cvtpk(S[k4][8 * s2 + 0], S[k4][8 * s2 + 1]); pk.y = cvtpk(S[k4][8 * s2 + 2], S[k4][8 * s2 + 3]); pk.z = cvtpk(S[k4][8 * s2 + 4], S[k4][8 * s2 + 5]); pk.w = cvtpk(S[k4][8 * s2 + 6], S[k4][8 * s2 + 7]);
                            const bf16x8 sb8 = __builtin_bit_cast(bf16x8, pk);
#pragma unroll
                            for (int tb = 0; tb < 2; ++tb) {
                                const s16x4 a0 = *(const LAS s16x4*)(L + GL_QI + tb * 8192 + off_a(r, 4 * k4 + 2 * s2) + 8 * h);
                                const s16x4 a1 = *(const LAS s16x4*)(L + GL_QI + tb * 8192 + off_a(r, 4 * k4 + 2 * s2 + 1) + 8 * h);
                                oacc[tb] = MFMA32(cat8(a0, a1), sb8, oacc[tb]);
                            }
                            asm volatile("" ::: "memory");
                        }
#pragma unroll
                    for (int tb = 0; tb < 2; ++tb)
#pragma unroll
                        for (int ks = 0; ks < 4; ++ks) {
                            if (tb == 0 && ks >= 2) continue;
                            const bf16x8 pa = *(const LAS bf16x8*)(L + GL_PI + (32 * tb + r) * GL_PSTRIDE + (16 * ks + 8 * h) * 2);
                            oacc[tb] = MFMA32(pa, vf[ks], oacc[tb]);
                        }
                }
#pragma unroll
                for (int k4 = 0; k4 < 4; ++k4) {
#pragma unroll
                    for (int g = 0; g < 4; ++g) { const f32x4 dv4 = *(const LAS f32x4*)(DV + 32 * k4 + 8 * g + 4 * h);
                        S[k4][4 * g + 0] *= dv4.x; S[k4][4 * g + 1] *= dv4.y; S[k4][4 * g + 2] *= dv4.z; S[k4][4 * g + 3] *= dv4.w; }
#pragma unroll
                    for (int ks = 0; ks < 4; ++ks) {
                        LAS unsigned char* kb = L + GL_KH + (ks >> 1) * 8192; const unsigned ch = 4 * k4 + 2 * blk + (p4 >> 1);
                        const s16x4 lo = tr_read(kb + off_a(16 * (ks & 1) + 8 * h + q4, ch) + bo);
                        const s16x4 hi = tr_read(kb + off_a(16 * (ks & 1) + 8 * h + 4 + q4, ch) + bo);
                        S[k4] = MFMA32(cat8(lo, hi), vf[ks], S[k4]);
                    }
                    asm volatile("" ::: "memory");
                }
                __syncthreads();
                if (OUT) {
#pragma unroll
                    for (int tb = 0; tb < 2; ++tb)
#pragma unroll
                        for (int i = 0; i < 16; ++i) OS[(32 * tb + (i & 3) + 8 * (i >> 2) + 4 * h) * GL_OSP + 32 * w + r] = oacc[tb][i];
                    __syncthreads();
#pragma unroll
                    for (int rr = 0; rr < 8; ++rr) {
                        const int t = 8 * w + rr;
                        const f32x4 o = *(const LAS f32x4*)(OS + t * GL_OSP + 4 * lane);
                        const float ss = wave_sum((o.x * o.x + o.y * o.y) + (o.z * o.z + o.w * o.w));
                        const float rstd = __builtin_amdgcn_rsqf(ss * (1.f / GDV) + NORM_EPS);
                        bf16* yp = YG + (row0 + t) * YGW + 1024 + hd * GDV + 4 * lane;
                        const uint2 gg = *(const uint2*)yp;
                        const float g0 = bf2f(gg.x & 0xffff), g1 = bf2f(gg.x >> 16), g2 = bf2f(gg.y & 0xffff), g3 = bf2f(gg.y >> 16);
                        const float y0 = o.x * rstd * nw.x * (g0 * __builtin_amdgcn_rcpf(1.0f + __builtin_amdgcn_exp2f(-g0 * LOG2E)));
                        const float y1 = o.y * rstd * nw.y * (g1 * __builtin_amdgcn_rcpf(1.0f + __builtin_amdgcn_exp2f(-g1 * LOG2E)));
                        const float y2 = o.z * rstd * nw.z * (g2 * __builtin_amdgcn_rcpf(1.0f + __builtin_amdgcn_exp2f(-g2 * LOG2E)));
                        const float y3 = o.w * rstd * nw.w * (g3 * __builtin_amdgcn_rcpf(1.0f + __builtin_amdgcn_exp2f(-g3 * LOG2E)));
                        uint2 yo; yo.x = cvtpk(y0, y1); yo.y = cvtpk(y2, y3);
                        *(uint2*)yp = yo;
                    }
                    __syncthreads();
                }
            }
        }
        if (!OUT) {
#pragma unroll
            for (int k4 = 0; k4 < 4; ++k4)
#pragma unroll
                for (int i = 0; i < 16; ++i) sbase[(size_t)(32 * k4 + (i & 3) + 8 * (i >> 2) + 4 * h0) * GDV] = S[k4][i];
            if (F.tid < 16) {
#pragma unroll
                for (int e = 0; e < 8; ++e) DT[(size_t)(bh * 16 + sc) * GDK + 8 * F.tid + e] = __builtin_amdgcn_exp2f(sumB[e]); }
        }
    }
}

__device__ __forceinline__ void gla_scan(Frame& F, const Args& a) {
    float* LST = (float*)((char*)a.out + GLA_LST_OFF); const float* DT = (const float*)((char*)a.out + GLA_DT_OFF);
    for (int e = ((int)blockIdx.x * NWAVES * 64 + F.tid) * 4; e < 16 * GDK * GDV; e += F.G * NWAVES * 64 * 4) {
        const int bh = e >> 15, rem = e & 32767, dk = rem >> 8;
        f32x4* p = (f32x4*)(LST + (size_t)(bh * 16) * (GDK * GDV) + rem);
        const float* dp = DT + (size_t)(bh * 16) * GDK + dk;
        f32x4 Lv[15]; float d[15];
#pragma unroll
        for (int sc = 0; sc < 15; ++sc) { Lv[sc] = p[(size_t)sc * (GDK * GDV / 4)]; d[sc] = dp[sc * GDK]; }
        f32x4 S = {0.f, 0.f, 0.f, 0.f};
#pragma unroll
        for (int sc = 0; sc < 16; ++sc) { p[(size_t)sc * (GDK * GDV / 4)] = S; if (sc < 15) S = S * d[sc] + Lv[sc]; }
    }
}

__global__ void __launch_bounds__(NWAVES * 64, 2) hybrid_fwd(Args args) {
    extern __shared__ __attribute__((aligned(16))) unsigned char lds[];
    Frame F;
    F.lds = (LAS unsigned char*)lds;
    F.MISC = (volatile LAS unsigned*)(F.lds + MISC_OFF);
    F.tid = threadIdx.x; F.lane = F.tid & 63; F.wave = __builtin_amdgcn_readfirstlane(F.tid >> 6);
    F.G = gridDim.x; { const int bx = blockIdx.x; F.vcu = (F.G % 8 == 0) ? (bx % 8) * (F.G / 8) + bx / 8 : bx; }
    unsigned char* ws = args.ws;
    F.ctl = (gu32*)(ws + WS_CTL);
    for (int u = F.tid; u < (LDS_BYTES - LDSCTL_OFF) / 4; u += NWAVES * 64) ((LAS unsigned*)(F.lds + LDSCTL_OFF))[u] = 0u;
    __syncthreads();
    XcdBarrier bar = xcd_barrier_post((unsigned*)(F.ctl + CW_BAR) + args.li * XCD_BAR_WORDS, F.MISC + 8);
    const int lo = args.ph_lo, hi = args.ph_hi;
#define IN(k) (lo <= (k) && (k) < hi)
#define BOTH(k) (IN(k) && IN((k) + 1))

    if (IN(0)) { p0_prologue(F, args); if (BOTH(0)) xcd_barrier(bar); }

    if (IN(1)) {
        pg8::Gemm g{(const pg8::bf16_t*)args.out, (const pg8::bf16_t*)(ws + WS_WIN), M, NPROJ, D}; pg8::StaticOrder S; S.init(M, NPROJ, F.G, (int)blockIdx.x);
        pg8::EpiProj E{(pg8::bf16_t*)(ws + WS_P5), (pg8::bf16_t*)(ws + WS_YG), (const float*)(ws + WS_RS)};
        pg8::gemm_phase<pg8::EpiProj, pg8::StaticOrder, true, true>(F.lds + RING_OFF, g, S, E);
        if (BOTH(1)) xcd_barrier(bar);
    }

    if (IN(2)) {
        const bf16* P5 = (const bf16*)(ws + WS_P5); bf16* YG = (bf16*)(ws + WS_YG);
        gla_pass<false>(F, args);
        xcd_barrier(bar);
        gla_scan(F, args);
        gla_t0_exact(F, args);
        sb_phase(F, P5, YG, args.in[5]);
        xcd_barrier(bar);
        gla_pass<true>(F, args);
        if (BOTH(2)) xcd_barrier(bar);
    }

    if (IN(3)) {
        pg8::Gemm g{(const pg8::bf16_t*)(ws + WS_YG), (const pg8::bf16_t*)(ws + WS_WOUT), M, D, 2048}; pg8::StaticOrder S; S.init(M, D, F.G, (int)blockIdx.x);
        pg8::EpiF32 E{args.out, D};
        pg8::gemm_phase<pg8::EpiF32, pg8::StaticOrder, true, true>(F.lds + RING_OFF, g, S, E);
        if (BOTH(3)) xcd_barrier(bar);
    }

    if (IN(4)) p4_final(F, args);
#undef IN
#undef BOTH
}

extern "C" void kernel_launch(void* const* d_in, const int* in_sizes, int n_in, void* d_out, int out_size, void* d_ws, size_t ws_size, hipStream_t stream) {
    static int grid = 0;
    if (grid == 0) {
        if (n_in != 9 || in_sizes[0] != M * D || out_size != M * D || ws_size < WS_END) { fprintf(stderr, "kernel_launch: unexpected shapes (n_in %d, in0 %d, out %d, ws %zu)\n", n_in, n_in > 0 ? in_sizes[0] : -1, out_size, ws_size); grid = -1; return; }
        int dev = 0, cus = 0, per_cu = 0;
        if (hipGetDevice(&dev) != hipSuccess || hipDeviceGetAttribute(&cus, hipDeviceAttributeMultiprocessorCount, dev) != hipSuccess) { grid = -1; return; }
        if (hipFuncSetAttribute((const void*)hybrid_fwd, hipFuncAttributeMaxDynamicSharedMemorySize, LDS_BYTES) != hipSuccess) { fprintf(stderr, "kernel_launch: hipFuncSetAttribute failed\n"); grid = -1; return; }
        if (hipOccupancyMaxActiveBlocksPerMultiprocessor(&per_cu, (const void*)hybrid_fwd, NWAVES * 64, LDS_BYTES) != hipSuccess || per_cu < 1) { fprintf(stderr, "kernel_launch: occupancy query says %d blocks per CU\n", per_cu); grid = -1; (void)hipGetLastError(); return; }
        grid = cus;
    }
    if (grid < 0) return;
    (void)hipMemsetAsync((char*)d_ws + WS_CTL, 0, CTL_ZERO_BYTES, stream);
    Args a{};
    for (int i = 0; i < 9; ++i) a.in[i] = (const float*)d_in[i];
    a.out = (float*)d_out; a.ws = (unsigned char*)d_ws;
    a.ph_lo = 0; a.ph_hi = 5; a.li = 0;
    hipLaunchKernelGGL(hybrid_fwd, dim3(grid), dim3(NWAVES * 64), LDS_BYTES, stream, a);
}
```
